# Optimizing an MI355X kernel written in HIP

```python
import jax, jax.numpy as jnp
from jax import lax
import numpy as np

D_MODEL = 1024
BATCH = 4
SEQ = 4096
DEPTH = 4

N_MIXERS = 3
SB_HEADS = 16
SB_HEAD_DIM = D_MODEL // SB_HEADS
SB_BLOCK = 128
SSD_EXPAND = 2
SSD_D_INNER = SSD_EXPAND * D_MODEL
SSD_HEAD_DIM = 64
SSD_HEADS = SSD_D_INNER // SSD_HEAD_DIM
SSD_GROUPS = 8
SSD_HPG = SSD_HEADS // SSD_GROUPS
SSD_STATE = 128
SSD_CONV = 4
SSD_CHUNK = 128
SSD_CONV_DIM = SSD_D_INNER + 2 * SSD_GROUPS * SSD_STATE
SSD_IN_DIM = SSD_D_INNER + SSD_CONV_DIM + SSD_HEADS
SSD_NORM_GROUP = SSD_D_INNER // SSD_GROUPS
SC_WIDTH = 3
D_FF = 2816
RMS_EPS = 1e-6
N_SB_LAYERS = (DEPTH + 2) // 3
N_SSD_LAYERS = (DEPTH + 1) // 3
N_SC_LAYERS = DEPTH // 3

kernel_name = "hybrid_sb_ssd_shortconv_macaron"


def rmsnorm(x, g):
    xf = x.astype(jnp.float32)
    y = xf * lax.rsqrt(jnp.mean(xf * xf, axis=-1, keepdims=True) + RMS_EPS)
    return (y * g.astype(jnp.float32)).astype(x.dtype)


def swiglu(x, w_gu, w_down):
    gate, up = jnp.split(x @ w_gu, 2, axis=-1)
    return (jax.nn.silu(gate) * up) @ w_down


def causal_depthwise_conv(x, w):
    k, c = w.shape
    return lax.conv_general_dilated(
        x, w[:, None, :].astype(x.dtype), window_strides=(1,), padding=[(k - 1, 0)],
        dimension_numbers=('NWC', 'WIO', 'NWC'), feature_group_count=c)


def stick_breaking_attention(x, w_qkv, w_o):
    b, l, _ = x.shape
    q, k, v = jnp.split(x @ w_qkv, 3, axis=-1)
    q = q.reshape(b, l, SB_HEADS, SB_HEAD_DIM)
    k = k.reshape(b, l, SB_HEADS, SB_HEAD_DIM)
    v = v.reshape(b, l, SB_HEADS, SB_HEAD_DIM)
    n_blk = l // SB_BLOCK
    q_blocks = jnp.moveaxis(q.reshape(b, n_blk, SB_BLOCK, SB_HEADS, SB_HEAD_DIM), 1, 0)
    key_pos = jnp.arange(l)
    scale = SB_HEAD_DIM ** -0.5

    def one_block(args):
        q_blk, blk = args
        z = jnp.einsum('bqhd,bkhd->bhqk', q_blk, k).astype(jnp.float32) * scale
        q_pos = blk * SB_BLOCK + jnp.arange(SB_BLOCK)
        mask = key_pos[None, :] < q_pos[:, None]
        log_beta = jax.nn.log_sigmoid(z)
        log_keep = jnp.where(mask, jax.nn.log_sigmoid(-z), 0.0)
        tail = lax.cumsum(log_keep, axis=3, reverse=True) - log_keep
        att = jnp.where(mask, jnp.exp(log_beta + tail), 0.0)
        return jnp.einsum('bhqk,bkhd->bqhd', att.astype(v.dtype), v)

    o = lax.map(one_block, (q_blocks, jnp.arange(n_blk)))
    o = jnp.moveaxis(o, 0, 1).reshape(b, l, D_MODEL)
    return o @ w_o


def ssd_chunked(xs, dt, a, bm, cm):
    b, l, g, r, p = xs.shape
    n = bm.shape[-1]
    nc, cl = l // SSD_CHUNK, SSD_CHUNK
    x_c = xs.reshape(b, nc, cl, g, r, p)
    dt_c = dt.reshape(b, nc, cl, g, r)
    b_c = bm.reshape(b, nc, cl, g, n)
    c_c = cm.reshape(b, nc, cl, g, n)
    a_cum = jnp.cumsum(dt_c * a, axis=2)
    seg = a_cum[:, :, :, None] - a_cum[:, :, None, :]
    causal = jnp.tril(jnp.ones((cl, cl), dtype=bool))[:, :, None, None]
    decay = jnp.exp(jnp.where(causal, seg, -jnp.inf))
    cb = jnp.einsum('bclgn,bcsgn->bclsg', c_c, b_c)
    w = cb[..., None] * decay * dt_c[:, :, None]
    y_diag = jnp.einsum('bclsgr,bcsgrp->bclgrp', w, x_c)
    a_last = a_cum[:, :, -1]
    to_end = jnp.exp(a_last[:, :, None] - a_cum) * dt_c
    states = jnp.einsum('bcsgn,bcsgr,bcsgrp->bcgrpn', b_c, to_end, x_c)

    def step(h, inp):
        st, al = inp
        return h * jnp.exp(al)[..., None, None] + st, h

    h0 = jnp.zeros((b, g, r, p, n), dtype=xs.dtype)
    _, h_prev = lax.scan(step, h0, (jnp.moveaxis(states, 1, 0), jnp.moveaxis(a_last, 1, 0)))
    h_prev = jnp.moveaxis(h_prev, 0, 1)
    y_off = jnp.einsum('bclgn,bcgrpn,bclgr->bclgrp', c_c, h_prev, jnp.exp(a_cum))
    return (y_diag + y_off).reshape(b, l, g, r, p)


def ssd_mixer(x, w_in, conv_w, conv_b, dt_bias, a_log, d_skip, norm_g, w_out):
    b, l, _ = x.shape
    z, xbc, dt = jnp.split(x @ w_in, [SSD_D_INNER, SSD_D_INNER + SSD_CONV_DIM], axis=-1)
    xbc = jax.nn.silu(causal_depthwise_conv(xbc, conv_w) + conv_b)
    xs, bm, cm = jnp.split(xbc, [SSD_D_INNER, SSD_D_INNER + SSD_GROUPS * SSD_STATE], axis=-1)
    xs = xs.astype(jnp.float32).reshape(b, l, SSD_GROUPS, SSD_HPG, SSD_HEAD_DIM)
    bm = bm.astype(jnp.float32).reshape(b, l, SSD_GROUPS, SSD_STATE)
    cm = cm.astype(jnp.float32).reshape(b, l, SSD_GROUPS, SSD_STATE)
    dt = jax.nn.softplus(dt.astype(jnp.float32) + dt_bias.astype(jnp.float32))
    dt = dt.reshape(b, l, SSD_GROUPS, SSD_HPG)
    a = -jnp.exp(a_log.astype(jnp.float32)).reshape(SSD_GROUPS, SSD_HPG)
    y = ssd_chunked(xs, dt, a, bm, cm)
    y = y + d_skip.astype(jnp.float32).reshape(SSD_GROUPS, SSD_HPG, 1) * xs
    y = y.reshape(b, l, SSD_D_INNER).astype(x.dtype) * jax.nn.silu(z)
    y = rmsnorm(y.reshape(b, l, SSD_GROUPS, SSD_NORM_GROUP),
                norm_g.reshape(SSD_GROUPS, SSD_NORM_GROUP)).reshape(b, l, SSD_D_INNER)
    return y @ w_out


def short_conv_mixer(x, w_in, conv_w, w_out):
    b_gate, c_gate, h = jnp.split(x @ w_in, 3, axis=-1)
    u = causal_depthwise_conv(c_gate * h, conv_w)
    return (b_gate * u) @ w_out


def setup_inputs(seed: int = 0) -> dict:
    key = jax.random.key(seed)
    ks = jax.random.split(key, 24)
    f32 = jnp.float32

    def wn(k, shape, fan_in):
        return jax.random.normal(k, shape, f32) * (fan_in ** -0.5)

    def gain(k, shape):
        return 1.0 + 0.01 * jax.random.normal(k, shape, f32)

    dt0 = jnp.exp(jax.random.uniform(ks[14], (N_SSD_LAYERS, SSD_HEADS), f32)
                  * (np.log(0.1) - np.log(0.001)) + np.log(0.001))
    dt_bias = dt0 + jnp.log(-jnp.expm1(-dt0))
    return {
        "x": jax.random.normal(ks[0], (BATCH, SEQ, D_MODEL), f32),
        "ffn1_norm": gain(ks[1], (DEPTH, D_MODEL)),
        "ffn1_w_gu": wn(ks[2], (DEPTH, D_MODEL, 2 * D_FF), D_MODEL),
        "ffn1_w_down": wn(ks[3], (DEPTH, D_FF, D_MODEL), D_FF),
        "mix_norm": gain(ks[4], (DEPTH, D_MODEL)),
        "ffn2_norm": gain(ks[5], (DEPTH, D_MODEL)),
        "ffn2_w_gu": wn(ks[6], (DEPTH, D_MODEL, 2 * D_FF), D_MODEL),
        "ffn2_w_down": wn(ks[7], (DEPTH, D_FF, D_MODEL), D_FF),
        "sb_w_qkv": wn(ks[8], (N_SB_LAYERS, D_MODEL, 3 * D_MODEL), D_MODEL),
        "sb_w_o": wn(ks[9], (N_SB_LAYERS, D_MODEL, D_MODEL), D_MODEL),
        "ssd_w_in": wn(ks[10], (N_SSD_LAYERS, D_MODEL, SSD_IN_DIM), D_MODEL),
        "ssd_conv_w": wn(ks[11], (N_SSD_LAYERS, SSD_CONV, SSD_CONV_DIM), SSD_CONV),
        "ssd_conv_b": 0.01 * jax.random.normal(ks[12], (N_SSD_LAYERS, SSD_CONV_DIM), f32),
        "ssd_dt_bias": dt_bias,
        "ssd_a_log": jnp.log(jax.random.uniform(ks[15], (N_SSD_LAYERS, SSD_HEADS), f32, 1.0, 16.0)),
        "ssd_d": gain(ks[16], (N_SSD_LAYERS, SSD_HEADS)),
        "ssd_norm": gain(ks[17], (N_SSD_LAYERS, SSD_D_INNER)),
        "ssd_w_out": wn(ks[18], (N_SSD_LAYERS, SSD_D_INNER, D_MODEL), SSD_D_INNER),
        "sc_w_in": wn(ks[19], (N_SC_LAYERS, D_MODEL, 3 * D_MODEL), D_MODEL),
        "sc_conv_w": wn(ks[20], (N_SC_LAYERS, SC_WIDTH, D_MODEL), SC_WIDTH),
        "sc_w_out": wn(ks[21], (N_SC_LAYERS, D_MODEL, D_MODEL), D_MODEL),
        "final_norm": gain(ks[22], (D_MODEL,)),
    }


def reference(x, ffn1_norm, ffn1_w_gu, ffn1_w_down, mix_norm, ffn2_norm, ffn2_w_gu, ffn2_w_down,
              sb_w_qkv, sb_w_o, ssd_w_in, ssd_conv_w, ssd_conv_b, ssd_dt_bias, ssd_a_log, ssd_d,
              ssd_norm, ssd_w_out, sc_w_in, sc_conv_w, sc_w_out, final_norm):
    for i in range(DEPTH):
        x = x + 0.5 * swiglu(rmsnorm(x, ffn1_norm[i]), ffn1_w_gu[i], ffn1_w_down[i])
        h = rmsnorm(x, mix_norm[i])
        kind, j = i % N_MIXERS, i // N_MIXERS
        if kind == 0:
            m = stick_breaking_attention(h, sb_w_qkv[j], sb_w_o[j])
        elif kind == 1:
            m = ssd_mixer(h, ssd_w_in[j], ssd_conv_w[j], ssd_conv_b[j], ssd_dt_bias[j],
                          ssd_a_log[j], ssd_d[j], ssd_norm[j], ssd_w_out[j])
        else:
            m = short_conv_mixer(h, sc_w_in[j], sc_conv_w[j], sc_w_out[j])
        x = x + m
        x = x + 0.5 * swiglu(rmsnorm(x, ffn2_norm[i]), ffn2_w_gu[i], ffn2_w_down[i])
    return rmsnorm(x, final_norm)
```

```cpp
#include <hip/hip_runtime.h>
#include <hip/hip_cooperative_groups.h>
#include <cstdio>
#include <cstdint>
namespace cg = cooperative_groups;
__device__ __forceinline__ int tid_l() { int t = threadIdx.x; asm volatile("" : "+v"(t)); return t; }
namespace pg8 {
#define PG8_LAS __attribute__((address_space(3)))
typedef unsigned short bf16_t;
typedef short bf16x8 __attribute__((ext_vector_type(8)));
typedef float f32x4 __attribute__((ext_vector_type(4)));
typedef unsigned u32x4 __attribute__((ext_vector_type(4)));
constexpr int BM = 256, BK = 64, HALF = 128, HTB = HALF * BK * 2  , STAGE_BYTES = 8 * HTB, NXCD = 8, WGM = 8;

__host__ __device__ __forceinline__ int lds_byte(int r, int c) { const int st = (r >> 4) * 2 + (c >> 5), rr = r & 15, cc = c & 31, ob = rr * 64 + cc * 2; return st * 1024 + (ob ^ (((ob >> 9) & 1) << 5)); }
__host__ __device__ __forceinline__ void stage_rc(int b, int& R, int& C) { const int st = b / 1024, sb = b % 1024, swz = sb ^ (((sb >> 9) & 1) << 5); R = (st >> 1) * 16 + swz / 64; C = (st & 1) * 32 + (swz % 64) / 2; }
__host__ __device__ __forceinline__ int perm32(int rho) { const int n = rho >> 4, i = rho & 15; return 8 * (i >> 2) + 4 * n + (i & 3); }

struct Unit { int pm, pn; };
struct Gemm { const bf16_t* A; const bf16_t* Bt; int M, N, K; };

struct StaticOrder {
    int nM, nN, nwg, G, c;
    __host__ __device__ void init(int M, int N, int G_, int c_) { nM = M / BM; nN = N / BM; nwg = nM * nN; G = G_; c = c_; }
    __host__ __device__ bool next(int i, Unit& u) const {
        const long L = (long)i * G + c; if (L >= nwg) return false;
        int wgid = (int)L; { const int q = nwg / NXCD, r = nwg % NXCD, xcd = wgid % NXCD, off = wgid / NXCD; wgid = (xcd < r ? xcd * (q + 1) : r * (q + 1) + (xcd - r) * q) + off; }
        const int nig = WGM * nN, gid = wgid / nig, fm = gid * WGM, gsz = (nM - fm) < WGM ? (nM - fm) : WGM;
        u.pm = fm + ((wgid % nig) % gsz); u.pn = (wgid % nig) / gsz; return true;
    }
    __device__ __forceinline__ void a_ready(const Unit&) const {}
    __device__ __forceinline__ void done(const Unit&) const {}
};

typedef float f32x2_cv __attribute__((ext_vector_type(2))); typedef __bf16 bf16x2_cv __attribute__((ext_vector_type(2)));
__device__ __forceinline__ unsigned cvt_pk_bf16(float lo, float hi) { f32x2_cv v = {lo, hi}; bf16x2_cv b = __builtin_convertvector(v, bf16x2_cv); return __builtin_bit_cast(unsigned, b); }
template <class Epi, class Sched, bool ALIGN_EPI = false, bool SP2 = false>
__device__ __forceinline__ void gemm_phase(PG8_LAS unsigned char* lds, const Gemm g, const Sched& S, const Epi& E) {
    const int tid = tid_l(), wid = __builtin_amdgcn_readfirstlane(tid >> 6), lane = tid & 63, wr = wid >> 2, wc = wid & 3, fr = lane & 15, fq = lane >> 4;
    const int K = g.K, nt = K / BK;
    unsigned voffA[2], voffB[2];
#pragma unroll
    for (int i = 0; i < 2; ++i) { int R, C; stage_rc(tid * 16 + i * 8192, R, C); const int Rb = Epi::PERM ? ((R & ~31) + perm32(R & 31)) : R;
        voffA[i] = (unsigned)(R * K + C) * 2u; voffB[i] = (unsigned)(Rb * K + C) * 2u; }
    const size_t kstep = (size_t)(BK * 2);
    const size_t hstep = (size_t)HALF * K * 2;
    const size_t tstep = 2 * hstep;
    const unsigned ldsw = (unsigned)wid * 1024u;
    const int aoff = lds_byte(wr * 64 + fr, fq * 8), boff = lds_byte(wc * 32 + fr, fq * 8);
#define PG8_SA(b, h) (((b) * 2 + (h)) * HTB)
#define PG8_SB(b, h) ((4 + (b) * 2 + (h)) * HTB)
#define PG8_STAGE(bufoff, gbase, voff) do { _Pragma("unroll") for (int _i = 0; _i < 2; ++_i) \
        __builtin_amdgcn_global_load_lds((const unsigned*)((const char*)(gbase) + (voff)[_i]), (PG8_LAS unsigned*)(lds + (bufoff) + ldsw + _i * 8192), 16, 0, 0); } while (0)
#define PG8_LDA(dst, b, h) do { _Pragma("unroll") for (int m = 0; m < 4; ++m) _Pragma("unroll") for (int k = 0; k < 2; ++k) dst[m][k] = *(const PG8_LAS bf16x8*)(lds + PG8_SA(b, h) + aoff + m * 2048 + k * 1024); } while (0)
#define PG8_LDB(dst, b, h) do { _Pragma("unroll") for (int n = 0; n < 2; ++n) _Pragma("unroll") for (int k = 0; k < 2; ++k) dst[n][k] = *(const PG8_LAS bf16x8*)(lds + PG8_SB(b, h) + boff + n * 2048 + k * 1024); } while (0)
#define PG8_MMA(ai, bj, At, Bt) do { __builtin_amdgcn_s_setprio(1); _Pragma("unroll") for (int m = 0; m < 4; ++m) _Pragma("unroll") for (int n = 0; n < 2; ++n) _Pragma("unroll") for (int k = 0; k < 2; ++k) \
        acc[ai][bj][m][n] = __builtin_amdgcn_mfma_f32_16x16x32_bf16(Bt[n][k], At[m][k], acc[ai][bj][m][n], 0, 0, 0); __builtin_amdgcn_s_setprio(0); } while (0)
#define PG8_WAIT_V(n) asm volatile("s_waitcnt vmcnt(" #n ")" ::: "memory")
#define PG8_WAIT_L(n) asm volatile("s_waitcnt lgkmcnt(" #n ")" ::: "memory")
#define PG8_BAR __builtin_amdgcn_s_barrier()
#define PG8_SCHED __builtin_amdgcn_sched_barrier(0)
    Unit cur, nxt; int ui = 0;
    if (!S.next(0, cur)) return;
    f32x4 acc[2][2][4][2];
#pragma unroll
    for (int a = 0; a < 2; ++a)
#pragma unroll
        for (int b = 0; b < 2; ++b)
#pragma unroll
            for (int m = 0; m < 4; ++m)
#pragma unroll
                for (int n = 0; n < 2; ++n) acc[a][b][m][n] = (f32x4){0.f, 0.f, 0.f, 0.f};
    bf16x8 At[4][2], B0[2][2], B1[2][2];
    const char* cA = (const char*)g.A + (size_t)cur.pm * tstep; const char* cB = (const char*)g.Bt + (size_t)cur.pn * tstep;
    S.a_ready(cur);
    if constexpr (SP2) {
        PG8_STAGE(PG8_SB(0, 0), cB, voffB); PG8_STAGE(PG8_SB(0, 1), cB + hstep, voffB); PG8_STAGE(PG8_SA(0, 0), cA, voffA); PG8_STAGE(PG8_SA(0, 1), cA + hstep, voffA);
        if (wr == 1) PG8_BAR;
        PG8_WAIT_V(2); PG8_BAR;
        PG8_STAGE(PG8_SB(1, 0), cB + kstep, voffB); PG8_STAGE(PG8_SA(1, 0), cA + kstep, voffA); PG8_STAGE(PG8_SB(1, 1), cB + hstep + kstep, voffB);
        PG8_WAIT_V(6); PG8_BAR;
    } else {
        PG8_STAGE(PG8_SB(0, 0), cB, voffB); PG8_STAGE(PG8_SA(0, 0), cA, voffA); PG8_STAGE(PG8_SB(0, 1), cB + hstep, voffB); PG8_STAGE(PG8_SA(0, 1), cA + hstep, voffA);
        if (wr == 1) PG8_BAR;
        PG8_WAIT_V(4); PG8_BAR;
        PG8_STAGE(PG8_SB(1, 0), cB + kstep, voffB); PG8_STAGE(PG8_SA(1, 0), cA + kstep, voffA); PG8_STAGE(PG8_SB(1, 1), cB + hstep + kstep, voffB);
        PG8_WAIT_V(6); PG8_BAR;
    }
    for (;;) {
        const bool has_next = S.next(ui + 1, nxt);
        const char* nA = has_next ? (const char*)g.A + (size_t)nxt.pm * tstep : cA; const char* nB = has_next ? (const char*)g.Bt + (size_t)nxt.pn * tstep : cB;
        for (int t = 0; t < nt; t += 2) {
            const bool last = (t == nt - 2);
            const char* a1 = cA + (size_t)(t + 1) * kstep;
            const char* a2 = last ? nA : cA + (size_t)(t + 2) * kstep; const char* b2 = last ? nB : cB + (size_t)(t + 2) * kstep;
            const char* a3 = a2 + kstep; const char* b3 = b2 + kstep;
            if (last && has_next) S.a_ready(nxt);
            if constexpr (SP2) {
            PG8_LDB(B0, 0, 0); PG8_LDB(B1, 0, 1); PG8_SCHED; PG8_LDA(At, 0, 0); PG8_STAGE(PG8_SA(1, 1), a1 + hstep, voffA);
            PG8_WAIT_V(8); PG8_WAIT_L(0); PG8_BAR; PG8_MMA(0, 0, At, B0); PG8_MMA(0, 1, At, B1); PG8_BAR; PG8_SCHED;
            PG8_LDA(At, 0, 1); PG8_STAGE(PG8_SB(0, 0), b2, voffB); PG8_STAGE(PG8_SB(0, 1), b2 + hstep, voffB); PG8_STAGE(PG8_SA(0, 0), a2, voffA);
            PG8_WAIT_V(8); PG8_WAIT_L(0); PG8_BAR; PG8_MMA(1, 0, At, B0); PG8_MMA(1, 1, At, B1); PG8_BAR; PG8_SCHED;
            PG8_LDB(B0, 1, 0); PG8_LDB(B1, 1, 1); PG8_SCHED; PG8_LDA(At, 1, 0); PG8_STAGE(PG8_SA(0, 1), a2 + hstep, voffA);
            PG8_WAIT_V(8); PG8_WAIT_L(0); PG8_BAR; PG8_MMA(0, 0, At, B0); PG8_MMA(0, 1, At, B1); PG8_BAR; PG8_SCHED;
            PG8_LDA(At, 1, 1); PG8_STAGE(PG8_SB(1, 0), b3, voffB); PG8_STAGE(PG8_SB(1, 1), b3 + hstep, voffB); PG8_STAGE(PG8_SA(1, 0), a3, voffA);
            PG8_WAIT_V(8); PG8_WAIT_L(0); PG8_BAR; PG8_MMA(1, 0, At, B0); PG8_MMA(1, 1, At, B1); PG8_BAR; PG8_SCHED;
            } else {
            PG8_LDB(B0, 0, 0); PG8_SCHED; PG8_LDA(At, 0, 0); PG8_STAGE(PG8_SA(1, 1), a1 + hstep, voffA);
            PG8_WAIT_L(8); PG8_BAR; PG8_WAIT_L(0); PG8_MMA(0, 0, At, B0); PG8_BAR; PG8_SCHED;
            PG8_LDB(B1, 0, 1); PG8_STAGE(PG8_SB(0, 0), b2, voffB);
            PG8_BAR; PG8_WAIT_L(0); PG8_MMA(0, 1, At, B1); PG8_BAR;
            PG8_LDA(At, 0, 1); PG8_STAGE(PG8_SA(0, 0), a2, voffA);
            PG8_BAR; PG8_WAIT_L(0); PG8_MMA(1, 0, At, B0); PG8_BAR; PG8_SCHED;
            PG8_STAGE(PG8_SB(0, 1), b2 + hstep, voffB);
            PG8_WAIT_V(6); PG8_BAR; PG8_MMA(1, 1, At, B1); PG8_BAR;
            PG8_LDB(B0, 1, 0); PG8_SCHED; PG8_LDA(At, 1, 0); PG8_STAGE(PG8_SA(0, 1), a2 + hstep, voffA);
            PG8_WAIT_L(8); PG8_BAR; PG8_WAIT_L(0); PG8_MMA(0, 0, At, B0); PG8_BAR; PG8_SCHED;
            PG8_LDB(B1, 1, 1); PG8_STAGE(PG8_SB(1, 0), b3, voffB);
            PG8_BAR; PG8_WAIT_L(0); PG8_MMA(0, 1, At, B1); PG8_BAR;
            PG8_LDA(At, 1, 1); PG8_STAGE(PG8_SA(1, 0), a3, voffA);
            PG8_BAR; PG8_WAIT_L(0); PG8_MMA(1, 0, At, B0); PG8_BAR; PG8_SCHED;
            PG8_STAGE(PG8_SB(1, 1), b3 + hstep, voffB);
            PG8_WAIT_V(6); PG8_BAR; PG8_MMA(1, 1, At, B1); PG8_BAR;
            }
        }
        if constexpr (ALIGN_EPI) { if (wr == 0) PG8_BAR; }
        if constexpr (!Epi::AFTER_DRAIN) { E(acc, cur, wr, wc, fr, fq); S.done(cur); }
        if (!has_next) break;
#pragma unroll
        for (int a = 0; a < 2; ++a)
#pragma unroll
            for (int b = 0; b < 2; ++b)
#pragma unroll
                for (int m = 0; m < 4; ++m)
#pragma unroll
                    for (int n = 0; n < 2; ++n) acc[a][b][m][n] = (f32x4){0.f, 0.f, 0.f, 0.f};
        cur = nxt; cA = nA; cB = nB; ++ui;
        if constexpr (ALIGN_EPI) { if (wr == 1) PG8_BAR; }
    }
    PG8_WAIT_V(0);
    if constexpr (!ALIGN_EPI) { if (wr == 0) PG8_BAR; }
    PG8_BAR;
    if constexpr (Epi::AFTER_DRAIN) { E.fused(acc, cur, wr, wc, fr, fq, lds, wid, lane); S.done(cur); }
#undef PG8_SA
#undef PG8_SB
#undef PG8_STAGE
#undef PG8_LDA
#undef PG8_LDB
#undef PG8_MMA
#undef PG8_WAIT_V
#undef PG8_WAIT_L
#undef PG8_BAR
#undef PG8_SCHED
}
}
namespace pg8 {
typedef unsigned u32x2 __attribute__((ext_vector_type(2)));
constexpr float RMS_EPS = 1e-6f;
constexpr float LOG2E = 1.4426950408889634f;
__device__ __forceinline__ float silu_f(float x) { return x * __builtin_amdgcn_rcpf(1.0f + __builtin_amdgcn_exp2f(-x * LOG2E)); }
__device__ __forceinline__ float row_rstd(const float* rsp, int row, int fq) {
    const f32x4 v = *(const f32x4*)(rsp + (size_t)row * 16 + 4 * fq);
    float s = (v[0] + v[1]) + (v[2] + v[3]); s += __shfl_xor(s, 16); s += __shfl_xor(s, 32);
    return rsqrtf(s * (1.0f / 1024.0f) + RMS_EPS);
}
struct EpiSwiGLU {
    static constexpr bool PERM = true, AFTER_DRAIN = false;
    bf16_t* O; const float* rsp; int ldc;
    __device__ __forceinline__ void operator()(const f32x4 (&acc)[2][2][4][2], const Unit& u, int wr, int wc, int fr, int fq) const {
        const int row0 = u.pm * BM + wr * 64 + fr, col0 = u.pn * HALF + wc * 32 + 8 * fq;
#pragma unroll
        for (int ai = 0; ai < 2; ++ai)
#pragma unroll
            for (int m = 0; m < 4; ++m) {
                const int row = row0 + ai * HALF + m * 16; const float rs = row_rstd(rsp, row, fq);
                const f32x4 g0 = acc[ai][0][m][0] * rs, g1 = acc[ai][0][m][1] * rs, u0 = acc[ai][1][m][0] * rs, u1 = acc[ai][1][m][1] * rs;
                u32x4 w; w.x = cvt_pk_bf16(silu_f(g0[0]) * u0[0], silu_f(g0[1]) * u0[1]); w.y = cvt_pk_bf16(silu_f(g0[2]) * u0[2], silu_f(g0[3]) * u0[3]);
                w.z = cvt_pk_bf16(silu_f(g1[0]) * u1[0], silu_f(g1[1]) * u1[1]); w.w = cvt_pk_bf16(silu_f(g1[2]) * u1[2], silu_f(g1[3]) * u1[3]);
                *(u32x4*)(O + (size_t)row * ldc + col0) = w;
            }
    }
};
struct EpiSplit {
    static constexpr bool PERM = true, AFTER_DRAIN = false;
    bf16_t* O; int ldc; int tiles_per_split; size_t split_stride; const float* rsp; float scale0; float* dt_out; int dt_tile;
    __device__ __forceinline__ void operator()(const f32x4 (&acc)[2][2][4][2], const Unit& u, int wr, int wc, int fr, int fq) const {
        const int row0 = u.pm * BM + wr * 64 + fr;
        if (u.pn == dt_tile) {
            if (wc == 0) {
#pragma unroll
                for (int ai = 0; ai < 2; ++ai)
#pragma unroll
                    for (int m = 0; m < 4; ++m) {
                        const int row = row0 + ai * HALF + m * 16; const float rs = row_rstd(rsp, row, fq);
#pragma unroll
                        for (int n = 0; n < 2; ++n) *(f32x4*)(dt_out + (size_t)row * 32 + 8 * fq + 4 * n) = acc[ai][0][m][n] * rs;
                    }
            } else {
#pragma unroll
                for (int ai = 0; ai < 2; ++ai)
#pragma unroll
                    for (int m = 0; m < 4; ++m) (void)row_rstd(rsp, row0 + ai * HALF + m * 16, fq);
            }
            return;
        }
        const int t = u.pn / tiles_per_split; bf16_t* base = O + (size_t)t * split_stride; const int colt = (u.pn - t * tiles_per_split) * BM + wc * 32 + 8 * fq;
        const float sc = (t == 0) ? scale0 : 1.0f;
#pragma unroll
        for (int ai = 0; ai < 2; ++ai)
#pragma unroll
            for (int m = 0; m < 4; ++m) {
                const int row = row0 + ai * HALF + m * 16; const float rs = row_rstd(rsp, row, fq) * sc;
                bf16_t* rowp = base + (size_t)row * ldc + colt;
#pragma unroll
                for (int bj = 0; bj < 2; ++bj) {
                    const f32x4 v0 = acc[ai][bj][m][0] * rs, v1 = acc[ai][bj][m][1] * rs;
                    u32x4 w; w.x = cvt_pk_bf16(v0[0], v0[1]); w.y = cvt_pk_bf16(v0[2], v0[3]); w.z = cvt_pk_bf16(v1[0], v1[1]); w.w = cvt_pk_bf16(v1[2], v1[3]);
                    *(u32x4*)(rowp + bj * HALF) = w;
                }
            }
    }
};
struct EpiResid {
    static constexpr bool PERM = true, AFTER_DRAIN = false;
    bf16_t* XB; float* rsp_out; float alpha;
    __device__ __forceinline__ void operator()(const f32x4 (&acc)[2][2][4][2], const Unit& u, int wr, int wc, int fr, int fq) const {
        const int row0 = u.pm * BM + wr * 64 + fr, col0 = u.pn * BM + wc * 32 + 8 * fq;
#pragma unroll
        for (int ai = 0; ai < 2; ++ai)
#pragma unroll
            for (int m = 0; m < 4; ++m) {
                const int row = row0 + ai * HALF + m * 16; float ss = 0.f;
#pragma unroll
                for (int bj = 0; bj < 2; ++bj) {
                    const size_t off = (size_t)row * 1024 + col0 + bj * HALF;
                    const u32x4 xv = *(const u32x4*)(XB + off);
                    f32x4 x0 = {__uint_as_float(xv.x << 16), __uint_as_float(xv.x & 0xffff0000u), __uint_as_float(xv.y << 16), __uint_as_float(xv.y & 0xffff0000u)};
                    f32x4 x1 = {__uint_as_float(xv.z << 16), __uint_as_float(xv.z & 0xffff0000u), __uint_as_float(xv.w << 16), __uint_as_float(xv.w & 0xffff0000u)};
                    x0 = x0 + acc[ai][bj][m][0] * alpha; x1 = x1 + acc[ai][bj][m][1] * alpha;
                    u32x4 w; w.x = cvt_pk_bf16(x0[0], x0[1]); w.y = cvt_pk_bf16(x0[2], x0[3]); w.z = cvt_pk_bf16(x1[0], x1[1]); w.w = cvt_pk_bf16(x1[2], x1[3]);
                    *(u32x4*)(XB + off) = w;
                    ss += (x0[0] * x0[0] + x0[1] * x0[1]) + (x0[2] * x0[2] + x0[3] * x0[3]) + (x1[0] * x1[0] + x1[1] * x1[1]) + (x1[2] * x1[2] + x1[3] * x1[3]);
                }
                ss += __shfl_xor(ss, 16); ss += __shfl_xor(ss, 32);
                if (fq == 0) rsp_out[(size_t)row * 16 + u.pn * 4 + wc] = ss;
            }
    }
};
}
#define LAS __attribute__((address_space(3)))
typedef unsigned short bf16;
typedef float f32x4 __attribute__((ext_vector_type(4)));
typedef float f32x16 __attribute__((ext_vector_type(16)));
typedef short bf16x8 __attribute__((ext_vector_type(8)));
typedef unsigned u32x4 __attribute__((ext_vector_type(4)));
typedef unsigned u32x2 __attribute__((ext_vector_type(2)));
constexpr int NB = 4, SEQ = 4096, T = NB * SEQ, DM = 1024, FF = 2816, DEPTH = 4;
constexpr int SSD_IN = 6176, SSD_IN_PAD = 6400, NCHUNK = 32;
constexpr float RMS_EPS = 1e-6f, LOG2E = 1.4426950408889634f;
constexpr float SB_C2 = 0.125f * LOG2E;
constexpr size_t MiB = 1u << 20;
constexpr size_t WS_RSP = 0;
constexpr size_t WS_DT = 1 * MiB;
constexpr size_t WS_ACUM = 3 * MiB;
constexpr size_t WS_ALAST = 5 * MiB;
constexpr size_t WS_BAR = 5 * MiB + 256 * 1024;
constexpr size_t WS_XB = 5 * MiB + 512 * 1024;
constexpr size_t WS_W = WS_XB + 32 * MiB;
constexpr size_t W_GU1 = WS_W, W_D1 = W_GU1 + 11 * MiB, W_GU2 = W_D1 + 5 * MiB + 512 * 1024, W_D2 = W_GU2 + 11 * MiB, W_IN = W_D2 + 5 * MiB + 512 * 1024, W_OUT = W_IN + 12 * MiB + 512 * 1024;
constexpr size_t WS_AR = W_OUT + 4 * MiB;
constexpr size_t WS_END = WS_AR + 320 * MiB;
static_assert(WS_AR == 87 * MiB, "ws map");
constexpr int LDS_BYTES = 147456;
#ifndef MAXSTEP
#define MAXSTEP (8 * DEPTH)
#endif

struct Args { const float* in[22]; float* out; unsigned char* ws; };
typedef const Args __attribute__((address_space(4)))* ArgsP;
__device__ __forceinline__ ArgsP get_args() { ArgsP p = (ArgsP)__builtin_amdgcn_kernarg_segment_ptr(); asm volatile("" : "+s"(p)); return p; }

__device__ __forceinline__ unsigned cvt_pk(float lo, float hi) { return pg8::cvt_pk_bf16(lo, hi); }
__device__ __forceinline__ float bf_lo(unsigned u) { return __uint_as_float(u << 16); }
__device__ __forceinline__ float bf_hi(unsigned u) { return __uint_as_float(u & 0xffff0000u); }
__device__ __forceinline__ float bf_us(unsigned short u) { return __uint_as_float(((unsigned)u) << 16); }
__device__ __forceinline__ float silu_f(float x) { return x * __builtin_amdgcn_rcpf(1.0f + __builtin_amdgcn_exp2f(-x * LOG2E)); }
__device__ __forceinline__ float wave_sum(float v) {
#pragma unroll
    for (int o = 1; o < 64; o <<= 1) v += __shfl_xor(v, o);
    return v;
}
#define LDS_WAIT() asm volatile("s_waitcnt lgkmcnt(0)" ::: "memory")

struct TrDesc { const float* W; bf16* WT; const float* gain; int K, N, mode, item; };
struct TrRegs { f32x4 v[8]; float g[8]; };
__device__ __forceinline__ void tr_load(const TrDesc& d, TrRegs& R, int lane) {
    const int nblk = d.N / 32, kb = d.item / nblk, nb = d.item % nblk, k0 = 64 * kb, n0 = 32 * nb;
    const float* p = d.W + (size_t)(k0 + 2 * (lane >> 3)) * d.N + n0 + 4 * (lane & 7);
#pragma unroll
    for (int i = 0; i < 4; ++i) { R.v[2 * i] = *(const f32x4*)(p + (size_t)(16 * i) * d.N); R.v[2 * i + 1] = *(const f32x4*)(p + (size_t)(16 * i + 1) * d.N);
        R.g[2 * i] = d.gain ? d.gain[k0 + 2 * (lane >> 3) + 16 * i] : 1.0f; R.g[2 * i + 1] = d.gain ? d.gain[k0 + 2 * (lane >> 3) + 16 * i + 1] : 1.0f; }
}
__device__ __forceinline__ void tr_finish(const TrDesc& d, const TrRegs& R, LAS float* scrf, int lane) {
    LAS unsigned* scr = (LAS unsigned*)scrf;
    const int nblk = d.N / 32, kb = d.item / nblk, nb = d.item % nblk, k0 = 64 * kb, n0 = 32 * nb;
#pragma unroll
    for (int i = 0; i < 4; ++i) { const f32x4 a = R.v[2 * i] * R.g[2 * i], b = R.v[2 * i + 1] * R.g[2 * i + 1]; LAS unsigned* q = scr + (4 * (lane & 7)) * 36 + (lane >> 3) + 8 * i;
        q[0] = cvt_pk(a[0], b[0]); q[36] = cvt_pk(a[1], b[1]); q[72] = cvt_pk(a[2], b[2]); q[108] = cvt_pk(a[3], b[3]); }
    LDS_WAIT(); asm volatile("" ::: "memory");
    const int c = lane & 7;
#pragma unroll
    for (int j = 0; j < 4; ++j) {
        const int n = (lane >> 3) + 8 * j; const u32x4 o = *(const LAS u32x4*)(scr + n * 36 + 4 * c);
        int nn = n0 + n, row = nn;
        if (d.mode == 1) { const int up = nn >= FF; if (up) nn -= FF; row = 256 * (nn >> 7) + 128 * up + (nn & 127); }
        *(u32x4*)(d.WT + (size_t)row * d.K + k0 + 8 * c) = o;
    }
    LDS_WAIT(); asm volatile("" ::: "memory");
}

__device__ __forceinline__ void convert_layer(ArgsP ap, int layer, LAS unsigned char* lds, int segmask, int worker, int nworkers) {
    const int tid_ = tid_l(); const int lane = tid_ & 63, wave = __builtin_amdgcn_readfirstlane(tid_ >> 6);
    LAS float* scr = (LAS float*)(lds + wave * 16384);
    const int kind = layer % 3, j = layer / 3;
    unsigned char* ws = ap->ws;
    const int n_in = (kind == 1) ? SSD_IN : 3 * DM, k_out = (kind == 1) ? 2 * DM : DM;
    const float* w_in = (kind == 0) ? ap->in[8] + (size_t)j * DM * 3 * DM : (kind == 1) ? ap->in[10] + (size_t)j * DM * SSD_IN : ap->in[18] + (size_t)j * DM * 3 * DM;
    const float* w_out = (kind == 0) ? ap->in[9] + (size_t)j * DM * DM : (kind == 1) ? ap->in[17] + (size_t)j * 2 * DM * DM : ap->in[20] + (size_t)j * DM * DM;
    const int I_GU1 = (segmask & 1) ? (DM / 64) * (2 * FF / 32) : 0, I_GU2 = (segmask & 2) ? (DM / 64) * (2 * FF / 32) : 0, I_D1 = (segmask & 4) ? (FF / 64) * (DM / 32) : 0, I_D2 = (segmask & 8) ? (FF / 64) * (DM / 32) : 0;
    const int I_IN = (segmask & 16) ? (DM / 64) * (n_in / 32) : 0, I_OUT = (segmask & 32) ? (k_out / 64) * (DM / 32) : 0;
    const int total = I_GU1 + I_GU2 + I_D1 + I_D2 + I_IN + I_OUT;
    const int gw = worker * 8 + wave, NGW = nworkers * 8;
#define TR_DECODE(D, IT) do { int r_ = (IT); \
        if (r_ < I_GU1) { D = TrDesc{ap->in[2] + (size_t)layer * DM * 2 * FF, (bf16*)(ws + W_GU1), ap->in[1] + layer * DM, DM, 2 * FF, 1, r_}; break; } r_ -= I_GU1; \
        if (r_ < I_GU2) { D = TrDesc{ap->in[6] + (size_t)layer * DM * 2 * FF, (bf16*)(ws + W_GU2), ap->in[5] + layer * DM, DM, 2 * FF, 1, r_}; break; } r_ -= I_GU2; \
        if (r_ < I_D1) { D = TrDesc{ap->in[3] + (size_t)layer * FF * DM, (bf16*)(ws + W_D1), nullptr, FF, DM, 0, r_}; break; } r_ -= I_D1; \
        if (r_ < I_D2) { D = TrDesc{ap->in[7] + (size_t)layer * FF * DM, (bf16*)(ws + W_D2), nullptr, FF, DM, 0, r_}; break; } r_ -= I_D2; \
        if (r_ < I_IN) { D = TrDesc{w_in, (bf16*)(ws + W_IN), ap->in[4] + layer * DM, DM, n_in, 0, r_}; break; } r_ -= I_IN; \
        D = TrDesc{w_out, (bf16*)(ws + W_OUT), nullptr, k_out, DM, 0, r_}; } while (0)
    if (gw < total) {
        TrDesc cur; TrRegs rc; TR_DECODE(cur, gw); tr_load(cur, rc, lane);
        for (int it = gw; it < total; it += NGW) {
            TrDesc nxt = cur; TrRegs rn = rc; const bool has = (it + NGW < total);
            if (has) { TR_DECODE(nxt, it + NGW); tr_load(nxt, rn, lane); }
            tr_finish(cur, rc, scr, lane);
            cur = nxt; rc = rn;
        }
    }
#undef TR_DECODE
}

__device__ __forceinline__ void init_rows(ArgsP ap) {
    const int tid_ = tid_l(); const int lane = tid_ & 63, wave = tid_ >> 6;
    const int gw = blockIdx.x * 8 + wave, NGW = gridDim.x * 8;
    bf16* xb = (bf16*)(ap->ws + WS_XB); float* rsp = (float*)(ap->ws + WS_RSP);
    for (int row = gw; row < T; row += NGW) {
        const f32x4* xr = (const f32x4*)(ap->in[0] + (size_t)row * DM) + lane; u32x2* xbr = (u32x2*)(xb + (size_t)row * DM) + lane; float s = 0.f;
#pragma unroll
        for (int jj = 0; jj < 4; ++jj) { const f32x4 v = xr[64 * jj]; u32x2 w; w.x = cvt_pk(v[0], v[1]); w.y = cvt_pk(v[2], v[3]); xbr[64 * jj] = w; s += (v[0] * v[0] + v[1] * v[1]) + (v[2] * v[2] + v[3] * v[3]); }
        s = wave_sum(s);
        if (lane < 4) { f32x4 o = {0.f, 0.f, 0.f, 0.f}; if (lane == 0) o[0] = s; *(f32x4*)(rsp + (size_t)row * 16 + 4 * lane) = o; }
    }
}
__device__ __forceinline__ void final_norm(ArgsP ap) {
    const int tid_ = tid_l(); const int lane = tid_ & 63, wave = tid_ >> 6;
    const int gw = blockIdx.x * 8 + wave, NGW = gridDim.x * 8;
    const float* rsp = (const float*)(ap->ws + WS_RSP); const float* g = ap->in[21]; const bf16* xb = (const bf16*)(ap->ws + WS_XB);
    for (int row = gw; row < T; row += NGW) {
        float s = (lane < 16) ? rsp[(size_t)row * 16 + lane] : 0.f; s = wave_sum(s);
        const float rs = rsqrtf(s * (1.0f / DM) + RMS_EPS);
        f32x4* orow = (f32x4*)(ap->out + (size_t)row * DM) + lane; const f32x4* gr = (const f32x4*)g + lane; const u32x2* xr = (const u32x2*)(xb + (size_t)row * DM) + lane;
#pragma unroll
        for (int jj = 0; jj < 4; ++jj) { const u32x2 xv = xr[64 * jj]; const f32x4 gg = gr[64 * jj]; f32x4 v = {bf_lo(xv.x), bf_hi(xv.x), bf_lo(xv.y), bf_hi(xv.y)}; v = v * rs * gg; orow[64 * jj] = v; }
    }
}

__device__ __forceinline__ void shortconv_phase(const bf16* bg, const bf16* cgp, const bf16* hg, const float* cw, bf16* out) {
    const int nthr = gridDim.x * 512;
    for (int idx = blockIdx.x * 512 + tid_l(); idx < T * 128; idx += nthr) {
        const int row = idx >> 7, c8 = idx & 127, tpos = row & (SEQ - 1);
        float u[8];
#pragma unroll
        for (int e = 0; e < 8; ++e) u[e] = 0.f;
#pragma unroll
        for (int k = 0; k < 3; ++k) {
            if (tpos - 2 + k >= 0) {
                const size_t off = (size_t)(row - 2 + k) * DM + 8 * c8;
                const u32x4 cv = *(const u32x4*)(cgp + off), hv = *(const u32x4*)(hg + off);
                const f32x4 w0 = *(const f32x4*)(cw + k * DM + 8 * c8), w1 = *(const f32x4*)(cw + k * DM + 8 * c8 + 4);
#pragma unroll
                for (int q = 0; q < 4; ++q) { const float wl = (q < 2) ? w0[2 * q] : w1[2 * q - 4], wh = (q < 2) ? w0[2 * q + 1] : w1[2 * q - 3];
                    u[2 * q] += wl * (bf_lo(cv[q]) * bf_lo(hv[q])); u[2 * q + 1] += wh * (bf_hi(cv[q]) * bf_hi(hv[q])); }
            }
        }
        const u32x4 bv = *(const u32x4*)(bg + (size_t)row * DM + 8 * c8); u32x4 o;
#pragma unroll
        for (int q = 0; q < 4; ++q) o[q] = cvt_pk(bf_lo(bv[q]) * u[2 * q], bf_hi(bv[q]) * u[2 * q + 1]);
        *(u32x4*)(out + (size_t)row * DM + 8 * c8) = o;
    }
}
namespace sba {
constexpr int KS_OFF = 0, VT_OFF = 8192, VT_PITCH = 192, BUF_BYTES = VT_OFF + 64 * VT_PITCH, FLAG_OFF = 4 * BUF_BYTES;
typedef short v4i16_tr __attribute__((ext_vector_type(4)));
__device__ __forceinline__ void unit(LAS unsigned char* lds_all, const bf16* Q, const bf16* K, const bf16* V, bf16* O, int b, int hp, int qb) {
    const int tid = tid_l(), lane = tid & 63, r32 = lane & 31, hi = lane >> 5; const int wid = __builtin_amdgcn_readfirstlane(tid >> 6);
    const int hf = wid >> 2, h = 2 * hp + hf; LAS unsigned char* lds = lds_all + hf * (2 * BUF_BYTES);
    const size_t rowbase = (size_t)b * SEQ; const int q0 = qb * 128, qw0 = q0 + (wid & 3) * 32;
    bf16x8 qr[4];
    { const bf16* qp = Q + (rowbase + qw0 + r32) * DM + h * 64 + hi * 8;
#pragma unroll
      for (int d0 = 0; d0 < 4; ++d0) qr[d0] = *(const bf16x8*)(qp + d0 * 16); }
    f32x16 o0, o1;
#pragma unroll
    for (int r = 0; r < 16; ++r) { o0[r] = 0.f; o1[r] = 0.f; }
    float carry = 1.0f; bool done = false;
    const int NT = (q0 + 128) / 64;
    const int skey = (tid & 255) >> 2, sc = 2 * (tid & 3);
    const bf16* kg = K + (rowbase + skey) * DM + h * 64 + sc * 8; const bf16* vg = V + (rowbase + skey) * DM + h * 64 + sc * 8;
#define SBA_LOAD(TT) do { const size_t o_ = (size_t)(TT) * 64 * DM; kreg = *(const u32x4*)(kg + o_); kreg2 = *(const u32x4*)(kg + o_ + 8); vreg = *(const u32x4*)(vg + o_); vreg2 = *(const u32x4*)(vg + o_ + 8); } while (0)
    u32x4 kreg, kreg2, vreg, vreg2; SBA_LOAD(NT - 1);
#define SBA_STAGE(BUF) do { LAS unsigned char* bb_ = lds + (BUF) * BUF_BYTES; *(LAS u32x4*)(bb_ + KS_OFF + sc * 1024 + skey * 16) = kreg; *(LAS u32x4*)(bb_ + KS_OFF + (sc + 1) * 1024 + skey * 16) = kreg2; \
        *(LAS u32x4*)(bb_ + VT_OFF + skey * VT_PITCH + sc * 16) = vreg; *(LAS u32x4*)(bb_ + VT_OFF + skey * VT_PITCH + (sc + 1) * 16) = vreg2; } while (0)
    __syncthreads();
    SBA_STAGE(0);
    if (NT > 1) SBA_LOAD(NT - 2);
    __syncthreads();
    for (int t = NT - 1; t >= 0; --t) {
        const int cur = (NT - 1 - t) & 1;
        if (t > 0) SBA_STAGE(cur ^ 1);
        if (t > 1) SBA_LOAD(t - 2);
        if (!done && 64 * t <= qw0) {
            const LAS unsigned char* bb = lds + cur * BUF_BYTES;
            f32x16 p0, p1;
#pragma unroll
            for (int r = 0; r < 16; ++r) { p0[r] = 0.f; p1[r] = 0.f; }
            const LAS unsigned char* kb = bb + KS_OFF + hi * 1024 + r32 * 16;
#pragma unroll
            for (int d0 = 0; d0 < 4; ++d0) {
                const bf16x8 a0 = *(const LAS bf16x8*)(kb + d0 * 2048), a1 = *(const LAS bf16x8*)(kb + d0 * 2048 + 512);
                p0 = __builtin_amdgcn_mfma_f32_32x32x16_bf16(a0, qr[d0], p0, 0, 0, 0);
                p1 = __builtin_amdgcn_mfma_f32_32x32x16_bf16(a1, qr[d0], p1, 0, 0, 0);
            }
            const bool need_mask = (64 * t + 64 > qw0);
            const int qrel = qw0 + r32 - 64 * t;
            unsigned pw[16];
#pragma unroll
            for (int i = 7; i >= 0; --i) {
                const int half = i >> 2, rg = i & 3;
                f32x4 zv;
#pragma unroll
                for (int e = 0; e < 4; ++e) zv[e] = half ? p1[4 * rg + e] : p0[4 * rg + e];
                f32x4 ev;
#pragma unroll
                for (int e = 0; e < 4; ++e) ev[e] = __builtin_amdgcn_exp2f(-zv[e]);
                ev = ev + 1.0f;
                f32x4 bt;
#pragma unroll
                for (int e = 0; e < 4; ++e) bt[e] = __builtin_amdgcn_rcpf(ev[e]);
                if (need_mask) {
#pragma unroll
                    for (int e = 0; e < 4; ++e) { const int keyrel = 32 * half + 8 * rg + 4 * hi + e; if (keyrel >= qrel) bt[e] = 0.f; }
                }
                const f32x4 kp = 1.0f - bt;
                const float t3 = kp[3], t2 = t3 * kp[2], t1 = t2 * kp[1], tot = t1 * kp[0];
                const auto rr = __builtin_amdgcn_permlane32_swap(__float_as_uint(tot), __float_as_uint(tot), false, false);
                const float ta = __uint_as_float(rr[0]), tb = __uint_as_float(rr[1]);
                const float E = hi ? carry : carry * tb;
                carry = carry * (ta * tb);
                const f32x4 tv = {t1, t2, t3, 1.0f};
                const f32x4 pv = (bt * tv) * E;
                pw[2 * i] = cvt_pk(pv[0], pv[1]); pw[2 * i + 1] = cvt_pk(pv[2], pv[3]);
            }
            const LAS unsigned char* vb = bb + VT_OFF + (4 * hi + ((lane & 15) >> 2)) * VT_PITCH + (16 * ((lane >> 4) & 1) + 4 * (lane & 3)) * 2;
#pragma unroll
            for (int ks = 0; ks < 4; ++ks) {
                u32x4 bw; bw.x = pw[4 * ks]; bw.y = pw[4 * ks + 1]; bw.z = pw[4 * ks + 2]; bw.w = pw[4 * ks + 3];
                const bf16x8 bfrag = __builtin_bit_cast(bf16x8, bw);
#pragma unroll
                for (int dh = 0; dh < 2; ++dh) {
                    const v4i16_tr lo = __builtin_amdgcn_ds_read_tr16_b64_v4i16((LAS v4i16_tr*)(vb + (16 * ks) * VT_PITCH + dh * 64));
                    const v4i16_tr h2 = __builtin_amdgcn_ds_read_tr16_b64_v4i16((LAS v4i16_tr*)(vb + (16 * ks + 8) * VT_PITCH + dh * 64));
                    const bf16x8 afrag = (bf16x8){lo[0], lo[1], lo[2], lo[3], h2[0], h2[1], h2[2], h2[3]};
                    if (dh == 0) o0 = __builtin_amdgcn_mfma_f32_32x32x16_bf16(afrag, bfrag, o0, 0, 0, 0);
                    else o1 = __builtin_amdgcn_mfma_f32_32x32x16_bf16(afrag, bfrag, o1, 0, 0, 0);
                }
            }
            done = __all(carry == 0.0f);
        }
        if (lane == 0) *(LAS int*)(lds_all + FLAG_OFF + (cur * 8 + wid) * 4) = done ? 1 : 0;
        __syncthreads();
        { const u32x4 f0 = *(LAS u32x4*)(lds_all + FLAG_OFF + cur * 32), f1 = *(LAS u32x4*)(lds_all + FLAG_OFF + cur * 32 + 16);
          const unsigned alld = f0[0] & f0[1] & f0[2] & f0[3] & f1[0] & f1[1] & f1[2] & f1[3];
          if (__builtin_amdgcn_readfirstlane(alld) != 0u) break; }
    }
#undef SBA_STAGE
#undef SBA_LOAD
    bf16* op = O + (rowbase + qw0 + r32) * DM + h * 64 + 4 * hi;
#pragma unroll
    for (int rg = 0; rg < 4; ++rg) {
        u32x2 w0; w0.x = cvt_pk(o0[4 * rg], o0[4 * rg + 1]); w0.y = cvt_pk(o0[4 * rg + 2], o0[4 * rg + 3]); *(u32x2*)(op + 8 * rg) = w0;
        u32x2 w1; w1.x = cvt_pk(o1[4 * rg], o1[4 * rg + 1]); w1.y = cvt_pk(o1[4 * rg + 2], o1[4 * rg + 3]); *(u32x2*)(op + 32 + 8 * rg) = w1;
    }
}
__device__ __forceinline__ void phase(LAS unsigned char* lds, const bf16* Q, const bf16* K, const bf16* V, bf16* O) {
    for (int i = blockIdx.x; i < 1024; i += gridDim.x) {
        const int v = i & 255, rnd = i >> 8, bp = v >> 3, s = v & 7;
        const int qb = (rnd == 0) ? s : (rnd == 1) ? 15 - s : (rnd == 2) ? 16 + s : 31 - s;
        unit(lds, Q, K, V, O, bp >> 3, bp & 7, qb);
    }
}
}
namespace ssd {
constexpr int XN_OFF = 0, XN_PITCH = 528, BN_OFF = 128 * XN_PITCH, BN_PITCH = 272, CN_OFF = BN_OFF + 128 * BN_PITCH, DTV_OFF = CN_OFF + 128 * BN_PITCH, ACU_OFF = DTV_OFF + 2048, WTOT_OFF = ACU_OFF + 2048, S1_LDS = WTOT_OFF + 64;
static_assert(S1_LDS <= LDS_BYTES, "S1 LDS");
struct Bufs { const bf16* z; const bf16* xs_raw; const bf16* bc_raw; bf16* ypart; bf16* states; bf16* hprev; bf16* yn; bf16* cc; const float* dt_raw; float* acum; float* alast;
              const float* conv_w; const float* conv_b; const float* dt_bias; const float* a_log; const float* dsk; const float* ng; };

__device__ __forceinline__ u32x4 conv8(const bf16* src, size_t row, int tpos, int col, const float* cw, const float* cb, int cch) {
    float acc[8];
    { const f32x4 b0 = *(const f32x4*)(cb + cch), b1 = *(const f32x4*)(cb + cch + 4);
#pragma unroll
      for (int e = 0; e < 4; ++e) { acc[e] = b0[e]; acc[4 + e] = b1[e]; } }
#pragma unroll
    for (int k = 0; k < 4; ++k) {
        if (tpos - 3 + k >= 0) {
            const u32x4 raw = *(const u32x4*)(src + (row - 3 + k) * 2048 + col);
            const f32x4 w0 = *(const f32x4*)(cw + k * 4096 + cch), w1 = *(const f32x4*)(cw + k * 4096 + cch + 4);
            acc[0] += w0[0] * bf_lo(raw[0]); acc[1] += w0[1] * bf_hi(raw[0]); acc[2] += w0[2] * bf_lo(raw[1]); acc[3] += w0[3] * bf_hi(raw[1]);
            acc[4] += w1[0] * bf_lo(raw[2]); acc[5] += w1[1] * bf_hi(raw[2]); acc[6] += w1[2] * bf_lo(raw[3]); acc[7] += w1[3] * bf_hi(raw[3]);
        }
    }
    u32x4 o;
#pragma unroll
    for (int q = 0; q < 4; ++q) o[q] = cvt_pk(silu_f(acc[2 * q]), silu_f(acc[2 * q + 1]));
    return o;
}
typedef short v4i16_tr __attribute__((ext_vector_type(4)));
__device__ __forceinline__ bf16x8 tr8(const LAS unsigned char* p, int step_bytes) {
    const v4i16_tr lo = __builtin_amdgcn_ds_read_tr16_b64_v4i16((LAS v4i16_tr*)p), h2 = __builtin_amdgcn_ds_read_tr16_b64_v4i16((LAS v4i16_tr*)(p + step_bytes));
    return (bf16x8){lo[0], lo[1], lo[2], lo[3], h2[0], h2[1], h2[2], h2[3]};
}
__device__ __forceinline__ bf16x8 gather8(const LAS unsigned char* p, int pitch) {
    u32x4 w;
#pragma unroll
    for (int q = 0; q < 4; ++q) { const unsigned lo = *(const LAS unsigned short*)(p + (2 * q) * pitch), hh = *(const LAS unsigned short*)(p + (2 * q + 1) * pitch); w[q] = lo | (hh << 16); }
    return __builtin_bit_cast(bf16x8, w);
}

template <int NT> __device__ __forceinline__ void conv_load(u32x4 (&raw)[NT + 3], const bf16* src, size_t row0, int tpos0, int l0, int col) {
#pragma unroll
    for (int t = 0; t < NT + 3; ++t) { const int l = l0 - 3 + t; raw[t] = (u32x4){0u, 0u, 0u, 0u}; if (tpos0 + l >= 0) raw[t] = *(const u32x4*)(src + (row0 + l) * 2048 + col); }
}
template <int NT, class F> __device__ __forceinline__ void conv_compute(const u32x4 (&raw)[NT + 3], const float* cw, const float* cb, int cch, F out) {
    float w[4][8], bias[8];
#pragma unroll
    for (int k = 0; k < 4; ++k) { const f32x4 w0 = *(const f32x4*)(cw + k * 4096 + cch), w1 = *(const f32x4*)(cw + k * 4096 + cch + 4);
#pragma unroll
        for (int e = 0; e < 4; ++e) { w[k][e] = w0[e]; w[k][4 + e] = w1[e]; } }
    { const f32x4 b0 = *(const f32x4*)(cb + cch), b1 = *(const f32x4*)(cb + cch + 4);
#pragma unroll
      for (int e = 0; e < 4; ++e) { bias[e] = b0[e]; bias[4 + e] = b1[e]; } }
#pragma unroll
    for (int t = 0; t < NT; ++t) {
        float acc[8];
#pragma unroll
        for (int e = 0; e < 8; ++e) acc[e] = bias[e];
#pragma unroll
        for (int k = 0; k < 4; ++k) {
#pragma unroll
            for (int q = 0; q < 4; ++q) { acc[2 * q] += w[k][2 * q] * bf_lo(raw[t + k][q]); acc[2 * q + 1] += w[k][2 * q + 1] * bf_hi(raw[t + k][q]); }
        }
        u32x4 o;
#pragma unroll
        for (int q = 0; q < 4; ++q) o[q] = cvt_pk(silu_f(acc[2 * q]), silu_f(acc[2 * q + 1]));
        out(t, o);
    }
}

__device__ __forceinline__ void s1_item(LAS unsigned char* lds, const Bufs& B, int item) {
    const int tid = tid_l(), lane = tid & 63, r32 = lane & 31, hi = lane >> 5; const int wid = __builtin_amdgcn_readfirstlane(tid >> 6);
    const int g = item & 7, c = (item >> 3) & 31, b = item >> 8;
    const size_t row0 = (size_t)b * SEQ + c * 128; const int tpos0 = c * 128;
    const float dt_in = B.dt_raw[(row0 + (tid & 127)) * 32 + 4 * g + (tid >> 7)] + B.dt_bias[4 * g + (tid >> 7)], alog_in = B.a_log[4 * g + (tid >> 7)];
    __syncthreads();
    { const int c8x = tid & 31, l0x = 8 * (tid >> 5), c8 = tid & 15, l0 = 4 * (tid >> 4);
      u32x4 rx[11], rb[7], rc[7];
      conv_load<8>(rx, B.xs_raw, row0, tpos0, l0x, 256 * g + 8 * c8x);
      conv_load<4>(rb, B.bc_raw, row0, tpos0, l0, 128 * g + 8 * c8);
      conv_load<4>(rc, B.bc_raw, row0, tpos0, l0, 1024 + 128 * g + 8 * c8);
      conv_compute<8>(rx, B.conv_w, B.conv_b, 256 * g + 8 * c8x, [&](int t, u32x4 v) { *(LAS u32x4*)(lds + XN_OFF + (l0x + t) * XN_PITCH + c8x * 16) = v; });
      conv_compute<4>(rb, B.conv_w, B.conv_b, 2048 + 128 * g + 8 * c8, [&](int t, u32x4 v) { *(LAS u32x4*)(lds + BN_OFF + (l0 + t) * BN_PITCH + c8 * 16) = v; });
      conv_compute<4>(rc, B.conv_w, B.conv_b, 3072 + 128 * g + 8 * c8, [&](int t, u32x4 v) { *(LAS u32x4*)(lds + CN_OFF + (l0 + t) * BN_PITCH + c8 * 16) = v;
          *(u32x4*)(B.cc + (row0 + l0 + t) * 1024 + 128 * g + 8 * c8) = v; }); }
    float dtv, scan;
    { const int r = tid >> 7, l = tid & 127, hh = 4 * g + r;
      const float x = dt_in;
      dtv = (x > 20.f) ? x : log1pf(__expf(x));
      const float av = -__expf(alog_in);
      scan = dtv * av;
#pragma unroll
      for (int o = 1; o < 64; o <<= 1) { const float v = __shfl_up(scan, o); if (lane >= o) scan += v; }
      if (lane == 63) *(LAS float*)(lds + WTOT_OFF + wid * 4) = scan; }
    __syncthreads();
    { const int r = tid >> 7, l = tid & 127, hh = 4 * g + r;
      if (l >= 64) scan += *(LAS float*)(lds + WTOT_OFF + (wid - 1) * 4);
      *(LAS float*)(lds + ACU_OFF + (r * 128 + l) * 4) = scan; *(LAS float*)(lds + DTV_OFF + (r * 128 + l) * 4) = dtv;
      B.acum[(row0 + l) * 32 + hh] = scan;
      if (l == 127) B.alast[(b * NCHUNK + c) * 32 + hh] = scan; }
    __syncthreads();
    {
        const int r = wid >> 1, pb = wid & 1, head = 4 * g + r;
        const float al = *(const LAS float*)(lds + ACU_OFF + (r * 128 + 127) * 4);
        bf16x8 xa[8];
#pragma unroll
        for (int ks = 0; ks < 8; ++ks) {
            const int s0 = 16 * ks + 8 * hi;
            const f32x4 a0 = *(const LAS f32x4*)(lds + ACU_OFF + (r * 128 + s0) * 4), a1 = *(const LAS f32x4*)(lds + ACU_OFF + (r * 128 + s0 + 4) * 4);
            const f32x4 d0 = *(const LAS f32x4*)(lds + DTV_OFF + (r * 128 + s0) * 4), d1 = *(const LAS f32x4*)(lds + DTV_OFF + (r * 128 + s0 + 4) * 4);
            const bf16x8 xr8 = tr8(lds + XN_OFF + (s0 + ((lane & 15) >> 2)) * XN_PITCH + (64 * r + 32 * pb + 16 * ((lane >> 4) & 1) + 4 * (lane & 3)) * 2, 4 * XN_PITCH);
            float v[8];
#pragma unroll
            for (int j = 0; j < 8; ++j) { const float te = __expf(al - (j < 4 ? a0[j & 3] : a1[j & 3])) * (j < 4 ? d0[j & 3] : d1[j & 3]); v[j] = bf_us((unsigned short)xr8[j]) * te; }
            u32x4 w; w.x = cvt_pk(v[0], v[1]); w.y = cvt_pk(v[2], v[3]); w.z = cvt_pk(v[4], v[5]); w.w = cvt_pk(v[6], v[7]);
            xa[ks] = __builtin_bit_cast(bf16x8, w);
        }
        bf16* sp = B.states + ((((size_t)b * NCHUNK + c) * 32 + head) * 64 + 32 * pb + r32) * 128 + 4 * hi;
#pragma unroll 1
        for (int nb = 0; nb < 4; ++nb) {
            f32x16 st;
#pragma unroll
            for (int q = 0; q < 16; ++q) st[q] = 0.f;
#pragma unroll
            for (int ks = 0; ks < 8; ++ks) {
                const bf16x8 af = tr8(lds + BN_OFF + (16 * ks + 8 * hi + ((lane & 15) >> 2)) * BN_PITCH + (32 * nb + 16 * ((lane >> 4) & 1) + 4 * (lane & 3)) * 2, 4 * BN_PITCH);
                st = __builtin_amdgcn_mfma_f32_32x32x16_bf16(af, xa[ks], st, 0, 0, 0);
            }
#pragma unroll
            for (int rg = 0; rg < 4; ++rg) { u32x2 w; w.x = cvt_pk(st[4 * rg], st[4 * rg + 1]); w.y = cvt_pk(st[4 * rg + 2], st[4 * rg + 3]); *(u32x2*)(sp + 32 * nb + 8 * rg) = w; }
        }
    }
    const int lb = wid & 3, hp = wid >> 2, l = 32 * lb + r32;
    f32x16 yv[2][2];
    {
        bf16x8 cf[8];
#pragma unroll
        for (int k = 0; k < 8; ++k) cf[k] = *(const LAS bf16x8*)(lds + CN_OFF + l * BN_PITCH + (16 * k + 8 * hi) * 2);
        f32x16 cb[4];
#pragma unroll
        for (int sb = 0; sb < 4; ++sb) {
#pragma unroll
            for (int r = 0; r < 16; ++r) cb[sb][r] = 0.f;
            if (sb <= lb) {
#pragma unroll
                for (int k = 0; k < 8; ++k) { const bf16x8 af = *(const LAS bf16x8*)(lds + BN_OFF + (32 * sb + r32) * BN_PITCH + (16 * k + 8 * hi) * 2);
                    cb[sb] = __builtin_amdgcn_mfma_f32_32x32x16_bf16(af, cf[k], cb[sb], 0, 0, 0); }
            }
        }
#pragma unroll
        for (int hh = 0; hh < 2; ++hh) {
            const int r = 2 * hp + hh, head = 4 * g + r;
            const float acl = *(const LAS float*)(lds + ACU_OFF + (r * 128 + l) * 4);
            const float dsk = B.dsk[head];
            f32x16 y0, y1;
#pragma unroll
            for (int q = 0; q < 16; ++q) { y0[q] = 0.f; y1[q] = 0.f; }
#pragma unroll
            for (int sb = 0; sb < 4; ++sb) {
                if (sb <= lb) {
                    unsigned pwv[8];
#pragma unroll
                    for (int rg = 0; rg < 4; ++rg) {
                        const int sl = 32 * sb + 8 * rg + 4 * hi;
                        const f32x4 as4 = *(const LAS f32x4*)(lds + ACU_OFF + (r * 128 + sl) * 4), dt4 = *(const LAS f32x4*)(lds + DTV_OFF + (r * 128 + sl) * 4);
                        float w[4];
#pragma unroll
                        for (int e = 0; e < 4; ++e) { float v = cb[sb][4 * rg + e] * __expf(acl - as4[e]) * dt4[e]; if (sl + e > l) v = 0.f; if (sl + e == l) v += dsk; w[e] = v; }
                        pwv[2 * rg] = cvt_pk(w[0], w[1]); pwv[2 * rg + 1] = cvt_pk(w[2], w[3]);
                    }
#pragma unroll
                    for (int ks = 0; ks < 2; ++ks) {
                        u32x4 bw; bw.x = pwv[4 * ks]; bw.y = pwv[4 * ks + 1]; bw.z = pwv[4 * ks + 2]; bw.w = pwv[4 * ks + 3];
                        const bf16x8 bfrag = __builtin_bit_cast(bf16x8, bw);
                        const LAS unsigned char* xq = lds + XN_OFF + (32 * sb + 16 * ks + 4 * hi + ((lane & 15) >> 2)) * XN_PITCH + (64 * r + 16 * ((lane >> 4) & 1) + 4 * (lane & 3)) * 2;
#pragma unroll
                        for (int pb = 0; pb < 2; ++pb) {
                            const bf16x8 afrag = tr8(xq + pb * 64, 8 * XN_PITCH);
                            if (pb == 0) y0 = __builtin_amdgcn_mfma_f32_32x32x16_bf16(afrag, bfrag, y0, 0, 0, 0);
                            else y1 = __builtin_amdgcn_mfma_f32_32x32x16_bf16(afrag, bfrag, y1, 0, 0, 0);
                        }
                    }
                }
            }
            yv[hh][0] = y0; yv[hh][1] = y1;
        }
    }
    __syncthreads();
#pragma unroll
    for (int hh = 0; hh < 2; ++hh)
#pragma unroll
        for (int pb = 0; pb < 2; ++pb) {
            LAS unsigned char* yl = lds + XN_OFF + l * XN_PITCH + (64 * (2 * hp + hh) + 32 * pb + 4 * hi) * 2;
#pragma unroll
            for (int rg = 0; rg < 4; ++rg) { u32x2 w; w.x = cvt_pk(yv[hh][pb][4 * rg], yv[hh][pb][4 * rg + 1]); w.y = cvt_pk(yv[hh][pb][4 * rg + 2], yv[hh][pb][4 * rg + 3]); *(LAS u32x2*)(yl + 16 * rg) = w; }
        }
    __syncthreads();
#pragma unroll 4
    for (int i = 0; i < 8; ++i) { const int idx = tid + 512 * i, ll = idx >> 5, c8 = idx & 31;
        *(u32x4*)(B.ypart + (row0 + ll) * 2048 + 256 * g + 8 * c8) = *(const LAS u32x4*)(lds + XN_OFF + ll * XN_PITCH + c8 * 16); }
}

__device__ __forceinline__ void s2_phase(const Bufs& B) {
    const int nthr = gridDim.x * 512;
    for (int idx = blockIdx.x * 512 + tid_l(); idx < NB * 32 * 64 * 16; idx += nthr) {
        const int n8 = idx & 15, p = (idx >> 4) & 63, head = (idx >> 10) & 31, b = idx >> 15;
        float hacc[8];
#pragma unroll
        for (int e = 0; e < 8; ++e) hacc[e] = 0.f;
        const size_t base = (((size_t)b * NCHUNK) * 32 + head) * 8192 + p * 128 + 8 * n8;
        u32x4 nxt = *(const u32x4*)(B.states + base);
#pragma unroll 4
        for (int c = 0; c < NCHUNK; ++c) {
            const size_t off = base + (size_t)c * 32 * 8192;
            const u32x4 st = nxt;
            if (c + 1 < NCHUNK) nxt = *(const u32x4*)(B.states + off + (size_t)32 * 8192);
            u32x4 o;
#pragma unroll
            for (int q = 0; q < 4; ++q) o[q] = cvt_pk(hacc[2 * q], hacc[2 * q + 1]);
            *(u32x4*)(B.hprev + off) = o;
            const float dec = __expf(B.alast[(b * NCHUNK + c) * 32 + head]);
#pragma unroll
            for (int q = 0; q < 4; ++q) { hacc[2 * q] = hacc[2 * q] * dec + bf_lo(st[q]); hacc[2 * q + 1] = hacc[2 * q + 1] * dec + bf_hi(st[q]); }
        }
    }
}

constexpr int S3_Y = 0, S3_Z = 128 * XN_PITCH, S3_TAB = 2 * 128 * XN_PITCH;
__device__ __forceinline__ void s3_item(LAS unsigned char* lds, const Bufs& B, int item) {
    const int tid = tid_l(), lane = tid & 63, r32 = lane & 31, hi = lane >> 5; const int wid = __builtin_amdgcn_readfirstlane(tid >> 6);
    const int g = item & 7, c = (item >> 3) & 31, b = item >> 8;
    const int lb = wid & 3, hp = wid >> 2, l = 32 * lb + r32;
    const size_t row0 = (size_t)b * SEQ + c * 128, row = row0 + l;
    __syncthreads();
#pragma unroll 4
    for (int i = 0; i < 8; ++i) { const int idx = tid + 512 * i, ll = idx >> 5, c8 = idx & 31; const size_t off = (row0 + ll) * 2048 + 256 * g + 8 * c8;
        *(LAS u32x4*)(lds + S3_Y + ll * XN_PITCH + c8 * 16) = *(const u32x4*)(B.ypart + off);
        *(LAS u32x4*)(lds + S3_Z + ll * XN_PITCH + c8 * 16) = *(const u32x4*)(B.z + off); }
    bf16x8 cf[8];
#pragma unroll
    for (int k = 0; k < 8; ++k) cf[k] = *(const bf16x8*)(B.cc + row * 1024 + 128 * g + 16 * k + 8 * hi);
    const float ac0 = B.acum[row * 32 + 4 * g + 2 * hp], ac1 = B.acum[row * 32 + 4 * g + 2 * hp + 1];
    f32x16 y[2][2];
#pragma unroll
    for (int hh = 0; hh < 2; ++hh) {
        const int head = 4 * g + 2 * hp + hh;
        const bf16* hb = B.hprev + (((size_t)b * NCHUNK + c) * 32 + head) * 8192 + (size_t)r32 * 128 + 8 * hi;
#pragma unroll
        for (int pb = 0; pb < 2; ++pb) {
            f32x16 acc;
#pragma unroll
            for (int q = 0; q < 16; ++q) acc[q] = 0.f;
#pragma unroll
            for (int k = 0; k < 8; ++k) { const bf16x8 af = *(const bf16x8*)(hb + pb * 32 * 128 + 16 * k); acc = __builtin_amdgcn_mfma_f32_32x32x16_bf16(af, cf[k], acc, 0, 0, 0); }
            y[hh][pb] = acc;
        }
    }
    __syncthreads();
    float ss = 0.f;
#pragma unroll
    for (int hh = 0; hh < 2; ++hh) {
        const int r = 2 * hp + hh;
        const float ea = __expf(hh ? ac1 : ac0);
#pragma unroll
        for (int pb = 0; pb < 2; ++pb) {
            const int cl = 64 * r + 32 * pb + 4 * hi;
#pragma unroll
            for (int rg = 0; rg < 4; ++rg) {
                const u32x2 yp = *(const LAS u32x2*)(lds + S3_Y + l * XN_PITCH + (cl + 8 * rg) * 2), zz = *(const LAS u32x2*)(lds + S3_Z + l * XN_PITCH + (cl + 8 * rg) * 2);
                const float v0 = (bf_lo(yp.x) + ea * y[hh][pb][4 * rg]) * silu_f(bf_lo(zz.x)), v1 = (bf_hi(yp.x) + ea * y[hh][pb][4 * rg + 1]) * silu_f(bf_hi(zz.x));
                const float v2 = (bf_lo(yp.y) + ea * y[hh][pb][4 * rg + 2]) * silu_f(bf_lo(zz.y)), v3 = (bf_hi(yp.y) + ea * y[hh][pb][4 * rg + 3]) * silu_f(bf_hi(zz.y));
                y[hh][pb][4 * rg] = v0; y[hh][pb][4 * rg + 1] = v1; y[hh][pb][4 * rg + 2] = v2; y[hh][pb][4 * rg + 3] = v3;
                ss += (v0 * v0 + v1 * v1) + (v2 * v2 + v3 * v3);
            }
        }
    }
    ss += __shfl_xor(ss, 32);
    if (hi == 0) *(LAS float*)(lds + S3_TAB + (wid * 32 + r32) * 4) = ss;
    __syncthreads();
    const float tot = *(const LAS float*)(lds + S3_TAB + (wid * 32 + r32) * 4) + *(const LAS float*)(lds + S3_TAB + ((wid ^ 4) * 32 + r32) * 4);
    const float rs = rsqrtf(tot * (1.0f / 256.0f) + RMS_EPS);
#pragma unroll
    for (int hh = 0; hh < 2; ++hh)
#pragma unroll
        for (int pb = 0; pb < 2; ++pb) {
            const int cl = 64 * (2 * hp + hh) + 32 * pb + 4 * hi;
#pragma unroll
            for (int rg = 0; rg < 4; ++rg) {
                const f32x4 gg = *(const f32x4*)(B.ng + 256 * g + cl + 8 * rg);
                u32x2 w; w.x = cvt_pk(y[hh][pb][4 * rg] * rs * gg[0], y[hh][pb][4 * rg + 1] * rs * gg[1]); w.y = cvt_pk(y[hh][pb][4 * rg + 2] * rs * gg[2], y[hh][pb][4 * rg + 3] * rs * gg[3]);
                *(LAS u32x2*)(lds + S3_Y + l * XN_PITCH + (cl + 8 * rg) * 2) = w;
            }
        }
    __syncthreads();
#pragma unroll 4
    for (int i = 0; i < 8; ++i) { const int idx = tid + 512 * i, ll = idx >> 5, c8 = idx & 31;
        *(u32x4*)(B.yn + (row0 + ll) * 2048 + 256 * g + 8 * c8) = *(const LAS u32x4*)(lds + S3_Y + ll * XN_PITCH + c8 * 16); }
}
constexpr int S3W_PITCH = 144, S3W_TILE = 32 * S3W_PITCH, S3W_BYTES = 2 * S3W_TILE;
__device__ __forceinline__ void s3_wave_item(LAS unsigned char* wl, const Bufs& B, int witem, int lane) {
    const int r32 = lane & 31, hi = lane >> 5;
    const int lb = witem & 3, g = (witem >> 2) & 7, c = (witem >> 5) & 31, b = witem >> 10;
    const size_t row0 = (size_t)b * SEQ + c * 128 + 32 * lb, row = row0 + r32;
    LAS unsigned char* Yt = wl; LAS unsigned char* Zt = wl + S3W_TILE;
    bf16x8 cf[8];
#pragma unroll
    for (int k = 0; k < 8; ++k) cf[k] = *(const bf16x8*)(B.cc + row * 1024 + 128 * g + 16 * k + 8 * hi);
    const f32x4 ac4 = *(const f32x4*)(B.acum + row * 32 + 4 * g);
    unsigned yk[4][2][8]; float ss = 0.f;
    const int srow = lane >> 3, sch = lane & 7;
#pragma unroll
    for (int r = 0; r < 4; ++r) {
        const int head = 4 * g + r;
        const bf16* hb = B.hprev + (((size_t)b * NCHUNK + c) * 32 + head) * 8192 + (size_t)r32 * 128 + 8 * hi;
        u32x4 yl[4], zl[4];
#pragma unroll
        for (int i = 0; i < 4; ++i) { const size_t off = (row0 + srow + 8 * i) * 2048 + 256 * g + 64 * r + 8 * sch; yl[i] = *(const u32x4*)(B.ypart + off); zl[i] = *(const u32x4*)(B.z + off); }
        f32x16 accs[2];
#pragma unroll
        for (int pb = 0; pb < 2; ++pb) {
            f32x16 acc;
#pragma unroll
            for (int q = 0; q < 16; ++q) acc[q] = 0.f;
#pragma unroll
            for (int k = 0; k < 8; ++k) { const bf16x8 af = *(const bf16x8*)(hb + pb * 32 * 128 + 16 * k); acc = __builtin_amdgcn_mfma_f32_32x32x16_bf16(af, cf[k], acc, 0, 0, 0); }
            accs[pb] = acc;
        }
#pragma unroll
        for (int i = 0; i < 4; ++i) { *(LAS u32x4*)(Yt + (srow + 8 * i) * S3W_PITCH + sch * 16) = yl[i]; *(LAS u32x4*)(Zt + (srow + 8 * i) * S3W_PITCH + sch * 16) = zl[i]; }
        asm volatile("" ::: "memory");
        const float ea = __expf(ac4[r]);
#pragma unroll
        for (int pb = 0; pb < 2; ++pb)
#pragma unroll
            for (int rg = 0; rg < 4; ++rg) {
                const int cl = 32 * pb + 8 * rg + 4 * hi;
                const u32x2 yp = *(const LAS u32x2*)(Yt + r32 * S3W_PITCH + cl * 2), zz = *(const LAS u32x2*)(Zt + r32 * S3W_PITCH + cl * 2);
                const float v0 = (bf_lo(yp.x) + ea * accs[pb][4 * rg]) * silu_f(bf_lo(zz.x)), v1 = (bf_hi(yp.x) + ea * accs[pb][4 * rg + 1]) * silu_f(bf_hi(zz.x));
                const float v2 = (bf_lo(yp.y) + ea * accs[pb][4 * rg + 2]) * silu_f(bf_lo(zz.y)), v3 = (bf_hi(yp.y) + ea * accs[pb][4 * rg + 3]) * silu_f(bf_hi(zz.y));
                yk[r][pb][2 * rg] = cvt_pk(v0, v1); yk[r][pb][2 * rg + 1] = cvt_pk(v2, v3);
                ss += (v0 * v0 + v1 * v1) + (v2 * v2 + v3 * v3);
            }
        asm volatile("" ::: "memory");
    }
    ss += __shfl_xor(ss, 32);
    const float rs = rsqrtf(ss * (1.0f / 256.0f) + RMS_EPS);
#pragma unroll
    for (int r = 0; r < 4; ++r) {
        asm volatile("" ::: "memory");
#pragma unroll
        for (int pb = 0; pb < 2; ++pb)
#pragma unroll
            for (int rg = 0; rg < 4; ++rg) {
                const int cl = 32 * pb + 8 * rg + 4 * hi;
                const f32x4 gg = *(const f32x4*)(B.ng + 256 * g + 64 * r + cl);
                const unsigned p0 = yk[r][pb][2 * rg], p1 = yk[r][pb][2 * rg + 1];
                u32x2 w; w.x = cvt_pk(bf_lo(p0) * rs * gg[0], bf_hi(p0) * rs * gg[1]); w.y = cvt_pk(bf_lo(p1) * rs * gg[2], bf_hi(p1) * rs * gg[3]);
                *(LAS u32x2*)(Yt + r32 * S3W_PITCH + cl * 2) = w;
            }
        asm volatile("" ::: "memory");
#pragma unroll
        for (int i = 0; i < 4; ++i) *(u32x4*)(B.yn + (row0 + srow + 8 * i) * 2048 + 256 * g + 64 * r + 8 * sch) = *(const LAS u32x4*)(Yt + (srow + 8 * i) * S3W_PITCH + sch * 16);
    }
}
__device__ __forceinline__ void s3_phase(LAS unsigned char* lds, const Bufs& B) {
    const int tid = tid_l(), lane = tid & 63; const int wid = __builtin_amdgcn_readfirstlane(tid >> 6);
    LAS unsigned char* wl = lds + wid * S3W_BYTES;
    for (int wit = blockIdx.x * 8 + wid; wit < NB * NCHUNK * 8 * 4; wit += gridDim.x * 8) s3_wave_item(wl, B, wit, lane);
}
}
#define XB_TMO      128
#define XB_XCNT(j)  (256  + 64 * (j))
#define XB_XSUB(j)  (1280 + 64 * (j))
#define XB_XGEN(j)  (2304 + 64 * (j))
#define XB_TOP      3328
#define XB_TOPGEN   3392
#define XCD_BAR_WORDS 3456
#define XB_SPIN_CAP (1u << 18)

__device__ __forceinline__ unsigned xb_ld(unsigned* p)              { return __hip_atomic_load(p, __ATOMIC_RELAXED, __HIP_MEMORY_SCOPE_AGENT); }
__device__ __forceinline__ unsigned xb_add(unsigned* p, unsigned v) { return __hip_atomic_fetch_add(p, v, __ATOMIC_RELAXED, __HIP_MEMORY_SCOPE_AGENT); }
__device__ __forceinline__ unsigned xb_xcc_id() { return (unsigned)__builtin_amdgcn_s_getreg((3 << 11) | 20) & 0xFu; }
#define XB_SPIN(cond, bar) do { unsigned _sp = 0; while (cond) { __builtin_amdgcn_s_sleep(1); \
    if ((++_sp & 255u) == 0u) { if (xb_ld(&(bar)[XB_TMO])) break; if (_sp > XB_SPIN_CAP) { atomicAdd(&(bar)[XB_TMO], 1u); break; } } } } while (0)

struct XcdBarrier {
    unsigned* bar; unsigned x;
    volatile LAS unsigned* st;
};

__device__ __forceinline__ XcdBarrier xcd_barrier_post(unsigned* bar, volatile LAS unsigned* st) {
    XcdBarrier b; b.bar = bar; b.x = xb_xcc_id(); b.st = st;
    if (threadIdx.x == 0) (void)xb_add(&bar[XB_XCNT(b.x)], 1u);
    return b;
}
__device__ __forceinline__ void xcd_barrier_complete(unsigned* bar, unsigned x, unsigned& nloc, unsigned& nx) {
    const unsigned G = gridDim.x * gridDim.y * gridDim.z;
    unsigned sum, cnt, mine, sp = 0u;
    for (;;) {
        sum = 0u; cnt = 0u; mine = 0u;
#pragma unroll
        for (unsigned j = 0; j < 16; ++j) { const unsigned c = xb_ld(&bar[XB_XCNT(j)]); sum += c; cnt += (c > 0u) ? 1u : 0u; mine = (j == x) ? c : mine; }
        if (sum == G) break;
        __builtin_amdgcn_s_sleep(1);
        if ((++sp & 255u) == 0u) { if (xb_ld(&bar[XB_TMO])) break; if (sp > XB_SPIN_CAP) { atomicAdd(&bar[XB_TMO], 1u); break; } }
    }
    nloc = mine > 0u ? mine : 1u; nx = cnt > 0u ? cnt : 1u;
}

__device__ __forceinline__ void xcd_barrier(const XcdBarrier& b) {
    asm volatile("s_waitcnt vmcnt(0)" ::: "memory");
    __syncthreads();
    if (threadIdx.x == 0) {
        unsigned* bar = b.bar;
        __builtin_amdgcn_s_waitcnt(0);
        unsigned nloc = b.st[0], nx = b.st[1];
        if (nloc == 0u) { xcd_barrier_complete(bar, b.x, nloc, nx); b.st[0] = nloc; b.st[1] = nx; }
        const unsigned old = xb_add(&bar[XB_XSUB(b.x)], 1u);
        const unsigned gen = old / nloc;
        if (old + 1u == (gen + 1u) * nloc) {
            __builtin_amdgcn_fence(__ATOMIC_RELEASE, "agent");
            asm volatile("s_waitcnt vmcnt(0)" ::: "memory");
            const unsigned og = xb_add(&bar[XB_TOP], 1u);
            const unsigned tg = og / nx;
            if (og + 1u == (tg + 1u) * nx) xb_add(&bar[XB_TOPGEN], 1u);
            else XB_SPIN(xb_ld(&bar[XB_TOPGEN]) == tg, bar);
            __builtin_amdgcn_fence(__ATOMIC_ACQUIRE, "agent");
            xb_add(&bar[XB_XGEN(b.x)], 1u);
            asm volatile("s_waitcnt vmcnt(0)" ::: "memory");
        } else {
            XB_SPIN(xb_ld(&bar[XB_XGEN(b.x)]) == gen, bar);
            __builtin_amdgcn_fence(__ATOMIC_ACQUIRE, "agent");
            asm volatile("s_waitcnt vmcnt(0)" ::: "memory");
        }
    }
    __syncthreads();
}


__global__ void __launch_bounds__(512, 2) hybrid_fwd(Args a) {
    extern __shared__ __attribute__((aligned(16))) unsigned char lds_raw[];
    LAS unsigned char* lds = (LAS unsigned char*)lds_raw;
    cg::grid_group grid = cg::this_grid();
    volatile LAS unsigned* bst = (volatile LAS unsigned*)(lds + LDS_BYTES - 16);
    { const ArgsP a0 = get_args(); unsigned* bw = (unsigned*)(a0->ws + WS_BAR);
      if (tid_l() < 2) bst[tid_l()] = 0u;
      if (tid_l() == 0) (void)xb_add(bw + XB_XCNT(xb_xcc_id()), 1u);
      if (a0->ws == nullptr) grid.sync(); }
#define XSYNC() do { XcdBarrier xbar_; xbar_.bar = (unsigned*)(get_args()->ws + WS_BAR); xbar_.x = xb_xcc_id(); xbar_.st = bst; xcd_barrier(xbar_); } while (0)
#define GRID_SYNC() do { asm volatile("s_waitcnt vmcnt(0) lgkmcnt(0)" ::: "memory"); grid.sync(); __builtin_amdgcn_fence(__ATOMIC_ACQUIRE, "agent"); asm volatile("s_waitcnt vmcnt(0)" ::: "memory"); } while (0)
#define TAIL_CONVERT(NWG, LYR, MASK) do { const int rem_ = (NWG) % G; if (rem_ == 0) convert_layer(get_args(), (LYR), lds, (MASK), bx, G); else if (bx >= rem_) convert_layer(get_args(), (LYR), lds, (MASK), bx - rem_, G - rem_); } while (0)
#pragma unroll 1
    for (int step = 0; step < MAXSTEP; ++step) {
        const int layer = step >> 3, k = step & 7, kind = layer % 3;
        if (k == 0 && layer > 0) continue;
        const ArgsP a = get_args();
        unsigned char* ws = a->ws; float* rsp = (float*)(ws + WS_RSP); bf16* xb = (bf16*)(ws + WS_XB); bf16* ar = (bf16*)(ws + WS_AR);
        const int G = gridDim.x, bx = blockIdx.x;
#ifdef REPEAT_MASK
        const int nrep = (((REPEAT_MASK >> k) & 1) && !(k == 4 && kind == 1)) ? 2 : 1;
#else
        const int nrep = 1;
#endif
#pragma unroll 1
        for (int rep = 0; rep < nrep; ++rep) {
        const float alpha_mul = (rep + 1 == nrep) ? 1.0f : 0.0f;
        if (k == 0) {
#if !defined(NO_P0)
            if (layer == 0) init_rows(a);
            convert_layer(a, layer, lds, 63, bx, G);
#endif
        } else if (k == 1 || k == 6) {
            pg8::Gemm g{xb, (const bf16*)(ws + (k == 1 ? W_GU1 : W_GU2)), T, 2 * FF, DM}; pg8::StaticOrder S; S.init(T, 2 * FF, G, bx);
            pg8::EpiSwiGLU E{ar, rsp, FF};
#if !defined(NO_G1)
            pg8::gemm_phase<pg8::EpiSwiGLU, pg8::StaticOrder, true, true>(lds, g, S, E);
#endif
            if (k == 1 && layer > 0) TAIL_CONVERT((T / 256) * (2 * FF / 256), layer, 2 | 8);
            if (k == 6 && layer + 1 < DEPTH) TAIL_CONVERT((T / 256) * (2 * FF / 256), layer + 1, (kind == 1) ? (16 | 32) : (1 | 4 | 16 | 32));
        } else if (k == 2 || k == 7) {
            pg8::Gemm g{ar, (const bf16*)(ws + (k == 2 ? W_D1 : W_D2)), T, DM, FF}; pg8::StaticOrder S; S.init(T, DM, G, bx);
            pg8::EpiResid E{xb, rsp, 0.5f * alpha_mul};
#if !defined(NO_G2)
            pg8::gemm_phase<pg8::EpiResid, pg8::StaticOrder, true, true>(lds, g, S, E);
#endif
        } else if (k == 3) {
            const int n = (kind == 1) ? SSD_IN_PAD : 3 * DM;
            pg8::Gemm g{xb, (const bf16*)(ws + W_IN), T, n, DM}; pg8::StaticOrder S; S.init(T, n, G, bx);
            pg8::EpiSplit E;
            if (kind == 1) E = pg8::EpiSplit{ar, 2048, 8, (size_t)T * 2048, rsp, 1.0f, (float*)(ws + WS_DT), 24};
            else E = pg8::EpiSplit{ar, 1024, 4, (size_t)T * 1024, rsp, (kind == 0) ? SB_C2 : 1.0f, nullptr, -1};
#if !defined(NO_G3)
            pg8::gemm_phase<pg8::EpiSplit, pg8::StaticOrder, true, true>(lds, g, S, E);
#endif
            if (kind == 1 && layer + 1 < DEPTH) TAIL_CONVERT((T / 256) * (SSD_IN_PAD / 256), layer + 1, 1 | 4);
        } else if (k == 4) {
            if (kind == 0) {
#if !defined(NO_SBA)
                sba::phase(lds, ar, ar + (size_t)T * 1024, ar + (size_t)2 * T * 1024, ar + (size_t)3 * T * 1024);
#endif
            } else if (kind == 1) {
                ssd::Bufs B;
                B.z = ar; B.xs_raw = ar + (size_t)T * 2048; B.bc_raw = ar + (size_t)2 * T * 2048; B.ypart = ar + (size_t)3 * T * 2048; B.states = ar + (size_t)4 * T * 2048;
                B.hprev = ar + (size_t)T * 2048; B.yn = ar + (size_t)4 * T * 2048; B.cc = (bf16*)a->out;
                B.dt_raw = (const float*)(ws + WS_DT); B.acum = (float*)(ws + WS_ACUM); B.alast = (float*)(ws + WS_ALAST);
                B.conv_w = a->in[11]; B.conv_b = a->in[12]; B.dt_bias = a->in[13]; B.a_log = a->in[14]; B.dsk = a->in[15]; B.ng = a->in[16];
#if !defined(NO_S1)
                for (int it = bx; it < NB * NCHUNK * 8; it += G) ssd::s1_item(lds, B, it);
#endif
                XSYNC();
#if !defined(NO_S2)
                ssd::s2_phase(B);
#endif
                XSYNC();
#if !defined(NO_S3)
                ssd::s3_phase(lds, B);
#endif
            } else {
#if !defined(NO_SC)
                shortconv_phase(ar, ar + (size_t)T * 1024, ar + (size_t)2 * T * 1024, a->in[19] + (size_t)(layer / 3) * 3 * DM, ar + (size_t)3 * T * 1024);
#endif
            }
        } else {
            const int kk = (kind == 1) ? 2 * DM : DM;
#ifdef DBG_AZ
            const bf16* A = (kind == 1) ? ar + (size_t)DBG_AZ * T * 2048 : ar + (size_t)3 * T * 1024;
#else
            const bf16* A = (kind == 1) ? ar + (size_t)4 * T * 2048 : ar + (size_t)3 * T * 1024;
#endif
            pg8::Gemm g{A, (const bf16*)(ws + W_OUT), T, DM, kk}; pg8::StaticOrder S; S.init(T, DM, G, bx);
            pg8::EpiResid E{xb, rsp, alpha_mul};
#if !defined(NO_G4)
            pg8::gemm_phase<pg8::EpiResid, pg8::StaticOrder, true, true>(lds, g, S, E);
#endif
        }
        XSYNC();
#ifdef REPEAT_SYNC
        XSYNC();
#endif
        }
    }
    final_norm(get_args());
}

extern "C" void kernel_launch(void* const* d_in, const int* in_sizes, int n_in, void* d_out, int out_size, void* d_ws, size_t ws_size, hipStream_t stream) {
    static int grid = 0;
    if (grid == 0) {
        if (n_in != 22 || out_size != T * DM || ws_size < WS_END) { fprintf(stderr, "kernel_launch: unexpected shapes: n_in %d out %d ws %zu (need %zu)\n", n_in, out_size, ws_size, (size_t)WS_END); grid = -1; return; }
        int dev = 0, cus = 0, per_cu = 0;
        hipGetDevice(&dev); hipDeviceGetAttribute(&cus, hipDeviceAttributeMultiprocessorCount, dev);
        if (hipFuncSetAttribute((const void*)hybrid_fwd, hipFuncAttributeMaxDynamicSharedMemorySize, LDS_BYTES) != hipSuccess) { fprintf(stderr, "kernel_launch: hipFuncSetAttribute failed\n"); grid = -1; return; }
        if (hipOccupancyMaxActiveBlocksPerMultiprocessor(&per_cu, (const void*)hybrid_fwd, 512, LDS_BYTES) != hipSuccess || per_cu < 1) { fprintf(stderr, "kernel_launch: occupancy query gave %d\n", per_cu); per_cu = 1; }
        (void)hipGetLastError();
        grid = cus * per_cu;
        fprintf(stderr, "kernel_launch: grid %d (%d CUs x %d)\n", grid, cus, per_cu);
    }
    if (grid < 0) return;
    Args a{};
    for (int i = 0; i < 22; ++i) a.in[i] = (const float*)d_in[i];
    a.out = (float*)d_out; a.ws = (unsigned char*)d_ws;
    if (hipMemsetAsync((char*)d_ws + WS_BAR, 0, XCD_BAR_WORDS * 4, stream) != hipSuccess) { fprintf(stderr, "kernel_launch: hipMemsetAsync failed\n"); return; }
    void* args[] = {&a};
    hipError_t e = hipLaunchCooperativeKernel((const void*)hybrid_fwd, dim3(grid), dim3(512), args, LDS_BYTES, stream);
    if (e != hipSuccess) fprintf(stderr, "kernel_launch: cooperative launch failed: %s (grid %d)\n", hipGetErrorString(e), grid);
}
```

```cpp
#include <hip/hip_runtime.h>
#include <hip/hip_cooperative_groups.h>
#include <cstdio>
#include <cstdint>
namespace cg = cooperative_groups;
__device__ __forceinline__ int tid_l() { int t = threadIdx.x; asm volatile("" : "+v"(t)); return t; }
namespace pg8 {
#define PG8_LAS __attribute__((address_space(3)))
typedef unsigned short bf16_t;
typedef short bf16x8 __attribute__((ext_vector_type(8)));
typedef float f32x4 __attribute__((ext_vector_type(4)));
typedef unsigned u32x4 __attribute__((ext_vector_type(4)));
constexpr int BM = 256, BK = 64, HALF = 128, HTB = HALF * BK * 2  , STAGE_BYTES = 8 * HTB, NXCD = 8, WGM = 8;

__host__ __device__ __forceinline__ int lds_byte(int r, int c) { const int st = (r >> 4) * 2 + (c >> 5), rr = r & 15, cc = c & 31, ob = rr * 64 + cc * 2; return st * 1024 + (ob ^ (((ob >> 9) & 1) << 5)); }
__host__ __device__ __forceinline__ void stage_rc(int b, int& R, int& C) { const int st = b / 1024, sb = b % 1024, swz = sb ^ (((sb >> 9) & 1) << 5); R = (st >> 1) * 16 + swz / 64; C = (st & 1) * 32 + (swz % 64) / 2; }
__host__ __device__ __forceinline__ int perm32(int rho) { const int n = rho >> 4, i = rho & 15; return 8 * (i >> 2) + 4 * n + (i & 3); }

struct Unit { int pm, pn; };
struct Gemm { const bf16_t* A; const bf16_t* Bt; int M, N, K; };

struct StaticOrder {
    int nM, nN, nwg, G, c;
    __host__ __device__ void init(int M, int N, int G_, int c_) { nM = M / BM; nN = N / BM; nwg = nM * nN; G = G_; c = c_; }
    __host__ __device__ bool next(int i, Unit& u) const {
        const long L = (long)i * G + c; if (L >= nwg) return false;
        int wgid = (int)L; { const int q = nwg / NXCD, r = nwg % NXCD, xcd = wgid % NXCD, off = wgid / NXCD; wgid = (xcd < r ? xcd * (q + 1) : r * (q + 1) + (xcd - r) * q) + off; }
        const int nig = WGM * nN, gid = wgid / nig, fm = gid * WGM, gsz = (nM - fm) < WGM ? (nM - fm) : WGM;
        u.pm = fm + ((wgid % nig) % gsz); u.pn = (wgid % nig) / gsz; return true;
    }
    __device__ __forceinline__ void a_ready(const Unit&) const {}
    __device__ __forceinline__ void done(const Unit&) const {}
};

typedef float f32x2_cv __attribute__((ext_vector_type(2))); typedef __bf16 bf16x2_cv __attribute__((ext_vector_type(2)));
__device__ __forceinline__ unsigned cvt_pk_bf16(float lo, float hi) { f32x2_cv v = {lo, hi}; bf16x2_cv b = __builtin_convertvector(v, bf16x2_cv); return __builtin_bit_cast(unsigned, b); }
template <class Epi, class Sched, bool ALIGN_EPI = false, bool SP2 = false>
__device__ __forceinline__ void gemm_phase(PG8_LAS unsigned char* lds, const Gemm g, const Sched& S, const Epi& E) {
    const int tid = tid_l(), wid = __builtin_amdgcn_readfirstlane(tid >> 6), lane = tid & 63, wr = wid >> 2, wc = wid & 3, fr = lane & 15, fq = lane >> 4;
    const int K = g.K, nt = K / BK;
    unsigned voffA[2], voffB[2];
#pragma unroll
    for (int i = 0; i < 2; ++i) { int R, C; stage_rc(tid * 16 + i * 8192, R, C); const int Rb = Epi::PERM ? ((R & ~31) + perm32(R & 31)) : R;
        voffA[i] = (unsigned)(R * K + C) * 2u; voffB[i] = (unsigned)(Rb * K + C) * 2u; }
    const size_t kstep = (size_t)(BK * 2);
    const size_t hstep = (size_t)HALF * K * 2;
    const size_t tstep = 2 * hstep;
    const unsigned ldsw = (unsigned)wid * 1024u;
    const int aoff = lds_byte(wr * 64 + fr, fq * 8), boff = lds_byte(wc * 32 + fr, fq * 8);
#define PG8_SA(b, h) (((b) * 2 + (h)) * HTB)
#define PG8_SB(b, h) ((4 + (b) * 2 + (h)) * HTB)
#define PG8_STAGE(bufoff, gbase, voff) do { _Pragma("unroll") for (int _i = 0; _i < 2; ++_i) \
        __builtin_amdgcn_global_load_lds((const unsigned*)((const char*)(gbase) + (voff)[_i]), (PG8_LAS unsigned*)(lds + (bufoff) + ldsw + _i * 8192), 16, 0, 0); } while (0)
#define PG8_LDA(dst, b, h) do { _Pragma("unroll") for (int m = 0; m < 4; ++m) _Pragma("unroll") for (int k = 0; k < 2; ++k) dst[m][k] = *(const PG8_LAS bf16x8*)(lds + PG8_SA(b, h) + aoff + m * 2048 + k * 1024); } while (0)
#define PG8_LDB(dst, b, h) do { _Pragma("unroll") for (int n = 0; n < 2; ++n) _Pragma("unroll") for (int k = 0; k < 2; ++k) dst[n][k] = *(const PG8_LAS bf16x8*)(lds + PG8_SB(b, h) + boff + n * 2048 + k * 1024); } while (0)
#define PG8_MMA(ai, bj, At, Bt) do { __builtin_amdgcn_s_setprio(1); _Pragma("unroll") for (int m = 0; m < 4; ++m) _Pragma("unroll") for (int n = 0; n < 2; ++n) _Pragma("unroll") for (int k = 0; k < 2; ++k) \
        acc[ai][bj][m][n] = __builtin_amdgcn_mfma_f32_16x16x32_bf16(Bt[n][k], At[m][k], acc[ai][bj][m][n], 0, 0, 0); __builtin_amdgcn_s_setprio(0); } while (0)
#define PG8_WAIT_V(n) asm volatile("s_waitcnt vmcnt(" #n ")" ::: "memory")
#define PG8_WAIT_L(n) asm volatile("s_waitcnt lgkmcnt(" #n ")" ::: "memory")
#define PG8_BAR __builtin_amdgcn_s_barrier()
#define PG8_SCHED __builtin_amdgcn_sched_barrier(0)
    Unit cur, nxt; int ui = 0;
    if (!S.next(0, cur)) return;
    f32x4 acc[2][2][4][2];
#pragma unroll
    for (int a = 0; a < 2; ++a)
#pragma unroll
        for (int b = 0; b < 2; ++b)
#pragma unroll
            for (int m = 0; m < 4; ++m)
#pragma unroll
                for (int n = 0; n < 2; ++n) acc[a][b][m][n] = (f32x4){0.f, 0.f, 0.f, 0.f};
    bf16x8 At[4][2], B0[2][2], B1[2][2];
    const char* cA = (const char*)g.A + (size_t)cur.pm * tstep; const char* cB = (const char*)g.Bt + (size_t)cur.pn * tstep;
    S.a_ready(cur);
    if constexpr (SP2) {
        PG8_STAGE(PG8_SB(0, 0), cB, voffB); PG8_STAGE(PG8_SB(0, 1), cB + hstep, voffB); PG8_STAGE(PG8_SA(0, 0), cA, voffA); PG8_STAGE(PG8_SA(0, 1), cA + hstep, voffA);
        if (wr == 1) PG8_BAR;
        PG8_WAIT_V(2); PG8_BAR;
        PG8_STAGE(PG8_SB(1, 0), cB + kstep, voffB); PG8_STAGE(PG8_SA(1, 0), cA + kstep, voffA); PG8_STAGE(PG8_SB(1, 1), cB + hstep + kstep, voffB);
        PG8_WAIT_V(6); PG8_BAR;
    } else {
        PG8_STAGE(PG8_SB(0, 0), cB, voffB); PG8_STAGE(PG8_SA(0, 0), cA, voffA); PG8_STAGE(PG8_SB(0, 1), cB + hstep, voffB); PG8_STAGE(PG8_SA(0, 1), cA + hstep, voffA);
        if (wr == 1) PG8_BAR;
        PG8_WAIT_V(4); PG8_BAR;
        PG8_STAGE(PG8_SB(1, 0), cB + kstep, voffB); PG8_STAGE(PG8_SA(1, 0), cA + kstep, voffA); PG8_STAGE(PG8_SB(1, 1), cB + hstep + kstep, voffB);
        PG8_WAIT_V(6); PG8_BAR;
    }
    for (;;) {
        const bool has_next = S.next(ui + 1, nxt);
        const char* nA = has_next ? (const char*)g.A + (size_t)nxt.pm * tstep : cA; const char* nB = has_next ? (const char*)g.Bt + (size_t)nxt.pn * tstep : cB;
        for (int t = 0; t < nt; t += 2) {
            const bool last = (t == nt - 2);
            const char* a1 = cA + (size_t)(t + 1) * kstep;
            const char* a2 = last ? nA : cA + (size_t)(t + 2) * kstep; const char* b2 = last ? nB : cB + (size_t)(t + 2) * kstep;
            const char* a3 = a2 + kstep; const char* b3 = b2 + kstep;
            if (last && has_next) S.a_ready(nxt);
            if constexpr (SP2) {
            PG8_LDB(B0, 0, 0); PG8_LDB(B1, 0, 1); PG8_SCHED; PG8_LDA(At, 0, 0); PG8_STAGE(PG8_SA(1, 1), a1 + hstep, voffA);
            PG8_WAIT_V(8); PG8_WAIT_L(0); PG8_BAR; PG8_MMA(0, 0, At, B0); PG8_MMA(0, 1, At, B1); PG8_BAR; PG8_SCHED;
            PG8_LDA(At, 0, 1); PG8_STAGE(PG8_SB(0, 0), b2, voffB); PG8_STAGE(PG8_SB(0, 1), b2 + hstep, voffB); PG8_STAGE(PG8_SA(0, 0), a2, voffA);
            PG8_WAIT_V(8); PG8_WAIT_L(0); PG8_BAR; PG8_MMA(1, 0, At, B0); PG8_MMA(1, 1, At, B1); PG8_BAR; PG8_SCHED;
            PG8_LDB(B0, 1, 0); PG8_LDB(B1, 1, 1); PG8_SCHED; PG8_LDA(At, 1, 0); PG8_STAGE(PG8_SA(0, 1), a2 + hstep, voffA);
            PG8_WAIT_V(8); PG8_WAIT_L(0); PG8_BAR; PG8_MMA(0, 0, At, B0); PG8_MMA(0, 1, At, B1); PG8_BAR; PG8_SCHED;
            PG8_LDA(At, 1, 1); PG8_STAGE(PG8_SB(1, 0), b3, voffB); PG8_STAGE(PG8_SB(1, 1), b3 + hstep, voffB); PG8_STAGE(PG8_SA(1, 0), a3, voffA);
            PG8_WAIT_V(8); PG8_WAIT_L(0); PG8_BAR; PG8_MMA(1, 0, At, B0); PG8_MMA(1, 1, At, B1); PG8_BAR; PG8_SCHED;
            } else {
            PG8_LDB(B0, 0, 0); PG8_SCHED; PG8_LDA(At, 0, 0); PG8_STAGE(PG8_SA(1, 1), a1 + hstep, voffA);
            PG8_WAIT_L(8); PG8_BAR; PG8_WAIT_L(0); PG8_MMA(0, 0, At, B0); PG8_BAR; PG8_SCHED;
            PG8_LDB(B1, 0, 1); PG8_STAGE(PG8_SB(0, 0), b2, voffB);
            PG8_BAR; PG8_WAIT_L(0); PG8_MMA(0, 1, At, B1); PG8_BAR;
            PG8_LDA(At, 0, 1); PG8_STAGE(PG8_SA(0, 0), a2, voffA);
            PG8_BAR; PG8_WAIT_L(0); PG8_MMA(1, 0, At, B0); PG8_BAR; PG8_SCHED;
            PG8_STAGE(PG8_SB(0, 1), b2 + hstep, voffB);
            PG8_WAIT_V(6); PG8_BAR; PG8_MMA(1, 1, At, B1); PG8_BAR;
            PG8_LDB(B0, 1, 0); PG8_SCHED; PG8_LDA(At, 1, 0); PG8_STAGE(PG8_SA(0, 1), a2 + hstep, voffA);
            PG8_WAIT_L(8); PG8_BAR; PG8_WAIT_L(0); PG8_MMA(0, 0, At, B0); PG8_BAR; PG8_SCHED;
            PG8_LDB(B1, 1, 1); PG8_STAGE(PG8_SB(1, 0), b3, voffB);
            PG8_BAR; PG8_WAIT_L(0); PG8_MMA(0, 1, At, B1); PG8_BAR;
            PG8_LDA(At, 1, 1); PG8_STAGE(PG8_SA(1, 0), a3, voffA);
            PG8_BAR; PG8_WAIT_L(0); PG8_MMA(1, 0, At, B0); PG8_BAR; PG8_SCHED;
            PG8_STAGE(PG8_SB(1, 1), b3 + hstep, voffB);
            PG8_WAIT_V(6); PG8_BAR; PG8_MMA(1, 1, At, B1); PG8_BAR;
            }
        }
        if constexpr (ALIGN_EPI) { if (wr == 0) PG8_BAR; }
        if constexpr (!Epi::AFTER_DRAIN) { E(acc, cur, wr, wc, fr, fq); S.done(cur); }
        if (!has_next) break;
#pragma unroll
        for (int a = 0; a < 2; ++a)
#pragma unroll
            for (int b = 0; b < 2; ++b)
#pragma unroll
                for (int m = 0; m < 4; ++m)
#pragma unroll
                    for (int n = 0; n < 2; ++n) acc[a][b][m][n] = (f32x4){0.f, 0.f, 0.f, 0.f};
        cur = nxt; cA = nA; cB = nB; ++ui;
        if constexpr (ALIGN_EPI) { if (wr == 1) PG8_BAR; }
    }
    PG8_WAIT_V(0);
    if constexpr (!ALIGN_EPI) { if (wr == 0) PG8_BAR; }
    PG8_BAR;
    if constexpr (Epi::AFTER_DRAIN) { E.fused(acc, cur, wr, wc, fr, fq, lds, wid, lane); S.done(cur); }
#undef PG8_SA
#undef PG8_SB
#undef PG8_STAGE
#undef PG8_LDA
#undef PG8_LDB
#undef PG8_MMA
#undef PG8_WAIT_V
#undef PG8_WAIT_L
#undef PG8_BAR
#undef PG8_SCHED
}
}
namespace pg8 {
typedef unsigned u32x2 __attribute__((ext_vector_type(2)));
constexpr float RMS_EPS = 1e-6f;
constexpr float LOG2E = 1.4426950408889634f;
__device__ __forceinline__ float silu_f(float x) { return x * __builtin_amdgcn_rcpf(1.0f + __builtin_amdgcn_exp2f(-x * LOG2E)); }
__device__ __forceinline__ float row_rstd(const float* rsp, int row, int fq) {
    const f32x4 v = *(const f32x4*)(rsp + (size_t)row * 16 + 4 * fq);
    float s = (v[0] + v[1]) + (v[2] + v[3]); s += __shfl_xor(s, 16); s += __shfl_xor(s, 32);
    return rsqrtf(s * (1.0f / 1024.0f) + RMS_EPS);
}
struct EpiSwiGLU {
    static constexpr bool PERM = true, AFTER_DRAIN = false;
    bf16_t* O; const float* rsp; int ldc;
    __device__ __forceinline__ void operator()(const f32x4 (&acc)[2][2][4][2], const Unit& u, int wr, int wc, int fr, int fq) const {
        const int row0 = u.pm * BM + wr * 64 + fr, col0 = u.pn * HALF + wc * 32 + 8 * fq;
#pragma unroll
        for (int ai = 0; ai < 2; ++ai)
#pragma unroll
            for (int m = 0; m < 4; ++m) {
                const int row = row0 + ai * HALF + m * 16; const float rs = row_rstd(rsp, row, fq);
                const f32x4 g0 = acc[ai][0][m][0] * rs, g1 = acc[ai][0][m][1] * rs, u0 = acc[ai][1][m][0] * rs, u1 = acc[ai][1][m][1] * rs;
                u32x4 w; w.x = cvt_pk_bf16(silu_f(g0[0]) * u0[0], silu_f(g0[1]) * u0[1]); w.y = cvt_pk_bf16(silu_f(g0[2]) * u0[2], silu_f(g0[3]) * u0[3]);
                w.z = cvt_pk_bf16(silu_f(g1[0]) * u1[0], silu_f(g1[1]) * u1[1]); w.w = cvt_pk_bf16(silu_f(g1[2]) * u1[2], silu_f(g1[3]) * u1[3]);
                *(u32x4*)(O + (size_t)row * ldc + col0) = w;
            }
    }
};
struct EpiSplit {
    static constexpr bool PERM = true, AFTER_DRAIN = false;
    bf16_t* O; int ldc; int tiles_per_split; size_t split_stride; const float* rsp; float scale0; float* dt_out; int dt_tile;
    __device__ __forceinline__ void operator()(const f32x4 (&acc)[2][2][4][2], const Unit& u, int wr, int wc, int fr, int fq) const {
        const int row0 = u.pm * BM + wr * 64 + fr;
        if (u.pn == dt_tile) {
            if (wc == 0) {
#pragma unroll
                for (int ai = 0; ai < 2; ++ai)
#pragma unroll
                    for (int m = 0; m < 4; ++m) {
                        const int row = row0 + ai * HALF + m * 16; const float rs = row_rstd(rsp, row, fq);
#pragma unroll
                        for (int n = 0; n < 2; ++n) *(f32x4*)(dt_out + (size_t)row * 32 + 8 * fq + 4 * n) = acc[ai][0][m][n] * rs;
                    }
            } else {
#pragma unroll
                for (int ai = 0; ai < 2; ++ai)
#pragma unroll
                    for (int m = 0; m < 4; ++m) (void)row_rstd(rsp, row0 + ai * HALF + m * 16, fq);
            }
            return;
        }
        const int t = u.pn / tiles_per_split; bf16_t* base = O + (size_t)t * split_stride; const int colt = (u.pn - t * tiles_per_split) * BM + wc * 32 + 8 * fq;
        const float sc = (t == 0) ? scale0 : 1.0f;
#pragma unroll
        for (int ai = 0; ai < 2; ++ai)
#pragma unroll
            for (int m = 0; m < 4; ++m) {
                const int row = row0 + ai * HALF + m * 16; const float rs = row_rstd(rsp, row, fq) * sc;
                bf16_t* rowp = base + (size_t)row * ldc + colt;
#pragma unroll
                for (int bj = 0; bj < 2; ++bj) {
                    const f32x4 v0 = acc[ai][bj][m][0] * rs, v1 = acc[ai][bj][m][1] * rs;
                    u32x4 w; w.x = cvt_pk_bf16(v0[0], v0[1]); w.y = cvt_pk_bf16(v0[2], v0[3]); w.z = cvt_pk_bf16(v1[0], v1[1]); w.w = cvt_pk_bf16(v1[2], v1[3]);
                    *(u32x4*)(rowp + bj * HALF) = w;
                }
            }
    }
};
struct EpiResid {
    static constexpr bool PERM = true, AFTER_DRAIN = false;
    bf16_t* XB; float* rsp_out; float alpha;
    __device__ __forceinline__ void operator()(const f32x4 (&acc)[2][2][4][2], const Unit& u, int wr, int wc, int fr, int fq) const {
        const int row0 = u.pm * BM + wr * 64 + fr, col0 = u.pn * BM + wc * 32 + 8 * fq;
#pragma unroll
        for (int ai = 0; ai < 2; ++ai)
#pragma unroll
            for (int m = 0; m < 4; ++m) {
                const int row = row0 + ai * HALF + m * 16; float ss = 0.f;
#pragma unroll
                for (int bj = 0; bj < 2; ++bj) {
                    const size_t off = (size_t)row * 1024 + col0 + bj * HALF;
                    const u32x4 xv = *(const u32x4*)(XB + off);
                    f32x4 x0 = {__uint_as_float(xv.x << 16), __uint_as_float(xv.x & 0xffff0000u), __uint_as_float(xv.y << 16), __uint_as_float(xv.y & 0xffff0000u)};
                    f32x4 x1 = {__uint_as_float(xv.z << 16), __uint_as_float(xv.z & 0xffff0000u), __uint_as_float(xv.w << 16), __uint_as_float(xv.w & 0xffff0000u)};
                    x0 = x0 + acc[ai][bj][m][0] * alpha; x1 = x1 + acc[ai][bj][m][1] * alpha;
                    u32x4 w; w.x = cvt_pk_bf16(x0[0], x0[1]); w.y = cvt_pk_bf16(x0[2], x0[3]); w.z = cvt_pk_bf16(x1[0], x1[1]); w.w = cvt_pk_bf16(x1[2], x1[3]);
                    *(u32x4*)(XB + off) = w;
                    ss += (x0[0] * x0[0] + x0[1] * x0[1]) + (x0[2] * x0[2] + x0[3] * x0[3]) + (x1[0] * x1[0] + x1[1] * x1[1]) + (x1[2] * x1[2] + x1[3] * x1[3]);
                }
                ss += __shfl_xor(ss, 16); ss += __shfl_xor(ss, 32);
                if (fq == 0) rsp_out[(size_t)row * 16 + u.pn * 4 + wc] = ss;
            }
    }
};
}
#define LAS __attribute__((address_space(3)))
typedef unsigned short bf16;
typedef float f32x4 __attribute__((ext_vector_type(4)));
typedef float f32x16 __attribute__((ext_vector_type(16)));
typedef short bf16x8 __attribute__((ext_vector_type(8)));
typedef unsigned u32x4 __attribute__((ext_vector_type(4)));
typedef unsigned u32x2 __attribute__((ext_vector_type(2)));
constexpr int NB = 4, SEQ = 4096, T = NB * SEQ, DM = 1024, FF = 2816, DEPTH = 4;
constexpr int SSD_IN = 6176, SSD_IN_PAD = 6400, NCHUNK = 32;
constexpr float RMS_EPS = 1e-6f, LOG2E = 1.4426950408889634f;
constexpr float SB_C2 = 0.125f * LOG2E;
constexpr size_t MiB = 1u << 20;
constexpr size_t WS_RSP = 0;
constexpr size_t WS_DT = 1 * MiB;
constexpr size_t WS_ACUM = 3 * MiB;
constexpr size_t WS_ALAST = 5 * MiB;
constexpr size_t WS_BAR = 5 * MiB + 256 * 1024;
constexpr size_t WS_XB = 5 * MiB + 512 * 1024;
constexpr size_t WS_W = WS_XB + 32 * MiB;
constexpr size_t W_GU1 = WS_W, W_D1 = W_GU1 + 11 * MiB, W_GU2 = W_D1 + 5 * MiB + 512 * 1024, W_D2 = W_GU2 + 11 * MiB, W_IN = W_D2 + 5 * MiB + 512 * 1024, W_OUT = W_IN + 12 * MiB + 512 * 1024;
constexpr size_t WS_AR = W_OUT + 4 * MiB;
constexpr size_t WS_END = WS_AR + 320 * MiB;
static_assert(WS_AR == 87 * MiB, "ws map");
constexpr int LDS_BYTES = 147456;
#ifndef MAXSTEP
#define MAXSTEP (8 * DEPTH)
#endif

struct Args { const float* in[22]; float* out; unsigned char* ws; };
typedef const Args __attribute__((address_space(4)))* ArgsP;
__device__ __forceinline__ ArgsP get_args() { ArgsP p = (ArgsP)__builtin_amdgcn_kernarg_segment_ptr(); asm volatile("" : "+s"(p)); return p; }

__device__ __forceinline__ unsigned cvt_pk(float lo, float hi) { return pg8::cvt_pk_bf16(lo, hi); }
__device__ __forceinline__ float bf_lo(unsigned u) { return __uint_as_float(u << 16); }
__device__ __forceinline__ float bf_hi(unsigned u) { return __uint_as_float(u & 0xffff0000u); }
__device__ __forceinline__ float bf_us(unsigned short u) { return __uint_as_float(((unsigned)u) << 16); }
__device__ __forceinline__ float silu_f(float x) { return x * __builtin_amdgcn_rcpf(1.0f + __builtin_amdgcn_exp2f(-x * LOG2E)); }
__device__ __forceinline__ float wave_sum(float v) {
#pragma unroll
    for (int o = 1; o < 64; o <<= 1) v += __shfl_xor(v, o);
    return v;
}
#define LDS_WAIT() asm volatile("s_waitcnt lgkmcnt(0)" ::: "memory")

struct TrDesc { const float* W; bf16* WT; const float* gain; int K, N, mode, item; };
struct TrRegs { f32x4 v[8]; float g[8]; };
__device__ __forceinline__ void tr_load(const TrDesc& d, TrRegs& R, int lane) {
    const int nblk = d.N / 32, kb = d.item / nblk, nb = d.item % nblk, k0 = 64 * kb, n0 = 32 * nb;
    const float* p = d.W + (size_t)(k0 + 2 * (lane >> 3)) * d.N + n0 + 4 * (lane & 7);
#pragma unroll
    for (int i = 0; i < 4; ++i) { R.v[2 * i] = *(const f32x4*)(p + (size_t)(16 * i) * d.N); R.v[2 * i + 1] = *(const f32x4*)(p + (size_t)(16 * i + 1) * d.N);
        R.g[2 * i] = d.gain ? d.gain[k0 + 2 * (lane >> 3) + 16 * i] : 1.0f; R.g[2 * i + 1] = d.gain ? d.gain[k0 + 2 * (lane >> 3) + 16 * i + 1] : 1.0f; }
}
__device__ __forceinline__ void tr_finish(const TrDesc& d, const TrRegs& R, LAS float* scrf, int lane) {
    LAS unsigned* scr = (LAS unsigned*)scrf;
    const int nblk = d.N / 32, kb = d.item / nblk, nb = d.item % nblk, k0 = 64 * kb, n0 = 32 * nb;
#pragma unroll
    for (int i = 0; i < 4; ++i) { const f32x4 a = R.v[2 * i] * R.g[2 * i], b = R.v[2 * i + 1] * R.g[2 * i + 1]; LAS unsigned* q = scr + (4 * (lane & 7)) * 36 + (lane >> 3) + 8 * i;
        q[0] = cvt_pk(a[0], b[0]); q[36] = cvt_pk(a[1], b[1]); q[72] = cvt_pk(a[2], b[2]); q[108] = cvt_pk(a[3], b[3]); }
    LDS_WAIT(); asm volatile("" ::: "memory");
    const int c = lane & 7;
#pragma unroll
    for (int j = 0; j < 4; ++j) {
        const int n = (lane >> 3) + 8 * j; const u32x4 o = *(const LAS u32x4*)(scr + n * 36 + 4 * c);
        int nn = n0 + n, row = nn;
        if (d.mode == 1) { const int up = nn >= FF; if (up) nn -= FF; row = 256 * (nn >> 7) + 128 * up + (nn & 127); }
        *(u32x4*)(d.WT + (size_t)row * d.K + k0 + 8 * c) = o;
    }
    LDS_WAIT(); asm volatile("" ::: "memory");
}

__device__ __forceinline__ void convert_layer(ArgsP ap, int layer, LAS unsigned char* lds, int segmask, int worker, int nworkers) {
    const int tid_ = tid_l(); const int lane = tid_ & 63, wave = __builtin_amdgcn_readfirstlane(tid_ >> 6);
    LAS float* scr = (LAS float*)(lds + wave * 16384);
    const int kind = layer % 3, j = layer / 3;
    unsigned char* ws = ap->ws;
    const int n_in = (kind == 1) ? SSD_IN : 3 * DM, k_out = (kind == 1) ? 2 * DM : DM;
    const float* w_in = (kind == 0) ? ap->in[8] + (size_t)j * DM * 3 * DM : (kind == 1) ? ap->in[10] + (size_t)j * DM * SSD_IN : ap->in[18] + (size_t)j * DM * 3 * DM;
    const float* w_out = (kind == 0) ? ap->in[9] + (size_t)j * DM * DM : (kind == 1) ? ap->in[17] + (size_t)j * 2 * DM * DM : ap->in[20] + (size_t)j * DM * DM;
    const int I_GU1 = (segmask & 1) ? (DM / 64) * (2 * FF / 32) : 0, I_GU2 = (segmask & 2) ? (DM / 64) * (2 * FF / 32) : 0, I_D1 = (segmask & 4) ? (FF / 64) * (DM / 32) : 0, I_D2 = (segmask & 8) ? (FF / 64) * (DM / 32) : 0;
    const int I_IN = (segmask & 16) ? (DM / 64) * (n_in / 32) : 0, I_OUT = (segmask & 32) ? (k_out / 64) * (DM / 32) : 0;
    const int total = I_GU1 + I_GU2 + I_D1 + I_D2 + I_IN + I_OUT;
    const int gw = worker * 8 + wave, NGW = nworkers * 8;
#define TR_DECODE(D, IT) do { int r_ = (IT); \
        if (r_ < I_GU1) { D = TrDesc{ap->in[2] + (size_t)layer * DM * 2 * FF, (bf16*)(ws + W_GU1), ap->in[1] + layer * DM, DM, 2 * FF, 1, r_}; break; } r_ -= I_GU1; \
        if (r_ < I_GU2) { D = TrDesc{ap->in[6] + (size_t)layer * DM * 2 * FF, (bf16*)(ws + W_GU2), ap->in[5] + layer * DM, DM, 2 * FF, 1, r_}; break; } r_ -= I_GU2; \
        if (r_ < I_D1) { D = TrDesc{ap->in[3] + (size_t)layer * FF * DM, (bf16*)(ws + W_D1), nullptr, FF, DM, 0, r_}; break; } r_ -= I_D1; \
        if (r_ < I_D2) { D = TrDesc{ap->in[7] + (size_t)layer * FF * DM, (bf16*)(ws + W_D2), nullptr, FF, DM, 0, r_}; break; } r_ -= I_D2; \
        if (r_ < I_IN) { D = TrDesc{w_in, (bf16*)(ws + W_IN), ap->in[4] + layer * DM, DM, n_in, 0, r_}; break; } r_ -= I_IN; \
        D = TrDesc{w_out, (bf16*)(ws + W_OUT), nullptr, k_out, DM, 0, r_}; } while (0)
    if (gw < total) {
        TrDesc cur; TrRegs rc; TR_DECODE(cur, gw); tr_load(cur, rc, lane);
        for (int it = gw; it < total; it += NGW) {
            TrDesc nxt = cur; TrRegs rn = rc; const bool has = (it + NGW < total);
            if (has) { TR_DECODE(nxt, it + NGW); tr_load(nxt, rn, lane); }
            tr_finish(cur, rc, scr, lane);
            cur = nxt; rc = rn;
        }
    }
#undef TR_DECODE
}

__device__ __forceinline__ void init_rows(ArgsP ap) {
    const int tid_ = tid_l(); const int lane = tid_ & 63, wave = tid_ >> 6;
    const int gw = blockIdx.x * 8 + wave, NGW = gridDim.x * 8;
    bf16* xb = (bf16*)(ap->ws + WS_XB); float* rsp = (float*)(ap->ws + WS_RSP);
    for (int row = gw; row < T; row += NGW) {
        const f32x4* xr = (const f32x4*)(ap->in[0] + (size_t)row * DM) + lane; u32x2* xbr = (u32x2*)(xb + (size_t)row * DM) + lane; float s = 0.f;
#pragma unroll
        for (int jj = 0; jj < 4; ++jj) { const f32x4 v = xr[64 * jj]; u32x2 w; w.x = cvt_pk(v[0], v[1]); w.y = cvt_pk(v[2], v[3]); xbr[64 * jj] = w; s += (v[0] * v[0] + v[1] * v[1]) + (v[2] * v[2] + v[3] * v[3]); }
        s = wave_sum(s);
        if (lane < 4) { f32x4 o = {0.f, 0.f, 0.f, 0.f}; if (lane == 0) o[0] = s; *(f32x4*)(rsp + (size_t)row * 16 + 4 * lane) = o; }
    }
}
__device__ __forceinline__ void final_norm(ArgsP ap) {
    const int tid_ = tid_l(); const int lane = tid_ & 63, wave = tid_ >> 6;
    const int gw = blockIdx.x * 8 + wave, NGW = gridDim.x * 8;
    const float* rsp = (const float*)(ap->ws + WS_RSP); const float* g = ap->in[21]; const bf16* xb = (const bf16*)(ap->ws + WS_XB);
    for (int row = gw; row < T; row += NGW) {
        float s = (lane < 16) ? rsp[(size_t)row * 16 + lane] : 0.f; s = wave_sum(s);
        const float rs = rsqrtf(s * (1.0f / DM) + RMS_EPS);
        f32x4* orow = (f32x4*)(ap->out + (size_t)row * DM) + lane; const f32x4* gr = (const f32x4*)g + lane; const u32x2* xr = (const u32x2*)(xb + (size_t)row * DM) + lane;
#pragma unroll
        for (int jj = 0; jj < 4; ++jj) { const u32x2 xv = xr[64 * jj]; const f32x4 gg = gr[64 * jj]; f32x4 v = {bf_lo(xv.x), bf_hi(xv.x), bf_lo(xv.y), bf_hi(xv.y)}; v = v * rs * gg; orow[64 * jj] = v; }
    }
}

__device__ __forceinline__ void shortconv_phase(const bf16* bg, const bf16* cgp, const bf16* hg, const float* cw, bf16* out) {
    const int nthr = gridDim.x * 512;
    for (int idx = blockIdx.x * 512 + tid_l(); idx < (T / 4) * 128; idx += nthr) {
        const int c8 = idx & 127, row0 = (idx >> 7) * 4, tpos0 = row0 & (SEQ - 1);
        f32x4 w0[3], w1[3];
#pragma unroll
        for (int k = 0; k < 3; ++k) { w0[k] = *(const f32x4*)(cw + k * DM + 8 * c8); w1[k] = *(const f32x4*)(cw + k * DM + 8 * c8 + 4); }
        f32x4 pa[6], pb[6];
        u32x4 bv[4];
#pragma unroll
        for (int t = 0; t < 6; ++t) {
            pa[t] = (f32x4){0.f, 0.f, 0.f, 0.f}; pb[t] = pa[t];
            if (tpos0 - 2 + t >= 0) {
                const size_t off = (size_t)(row0 - 2 + t) * DM + 8 * c8;
                const u32x4 cv = *(const u32x4*)(cgp + off), hv = *(const u32x4*)(hg + off);
                pa[t] = (f32x4){bf_lo(cv[0]) * bf_lo(hv[0]), bf_hi(cv[0]) * bf_hi(hv[0]), bf_lo(cv[1]) * bf_lo(hv[1]), bf_hi(cv[1]) * bf_hi(hv[1])};
                pb[t] = (f32x4){bf_lo(cv[2]) * bf_lo(hv[2]), bf_hi(cv[2]) * bf_hi(hv[2]), bf_lo(cv[3]) * bf_lo(hv[3]), bf_hi(cv[3]) * bf_hi(hv[3])};
            }
        }
#pragma unroll
        for (int t = 0; t < 4; ++t) bv[t] = *(const u32x4*)(bg + (size_t)(row0 + t) * DM + 8 * c8);
#pragma unroll
        for (int t = 0; t < 4; ++t) {
            const f32x4 ua = w0[0] * pa[t] + w0[1] * pa[t + 1] + w0[2] * pa[t + 2], ub = w1[0] * pb[t] + w1[1] * pb[t + 1] + w1[2] * pb[t + 2];
            u32x4 o; o[0] = cvt_pk(bf_lo(bv[t][0]) * ua[0], bf_hi(bv[t][0]) * ua[1]); o[1] = cvt_pk(bf_lo(bv[t][1]) * ua[2], bf_hi(bv[t][1]) * ua[3]);
            o[2] = cvt_pk(bf_lo(bv[t][2]) * ub[0], bf_hi(bv[t][2]) * ub[1]); o[3] = cvt_pk(bf_lo(bv[t][3]) * ub[2], bf_hi(bv[t][3]) * ub[3]);
            *(u32x4*)(out + (size_t)(row0 + t) * DM + 8 * c8) = o;
        }
    }
}
namespace sba {
constexpr int KS_OFF = 0, VT_OFF = 8192, VT_PITCH = 192, BUF_BYTES = VT_OFF + 64 * VT_PITCH, FLAG_OFF = 4 * BUF_BYTES;
typedef short v4i16_tr __attribute__((ext_vector_type(4)));
__device__ __forceinline__ void unit(LAS unsigned char* lds_all, const bf16* Q, const bf16* K, const bf16* V, bf16* O, int b, int hp, int qb) {
    const int tid = tid_l(), lane = tid & 63, r32 = lane & 31, hi = lane >> 5; const int wid = __builtin_amdgcn_readfirstlane(tid >> 6);
    const int hf = wid >> 2, h = 2 * hp + hf; LAS unsigned char* lds = lds_all + hf * (2 * BUF_BYTES);
    const size_t rowbase = (size_t)b * SEQ; const int q0 = qb * 128, qw0 = q0 + (wid & 3) * 32;
    bf16x8 qr[4];
    { const bf16* qp = Q + (rowbase + qw0 + r32) * DM + h * 64 + hi * 8;
#pragma unroll
      for (int d0 = 0; d0 < 4; ++d0) qr[d0] = *(const bf16x8*)(qp + d0 * 16); }
    f32x16 o0, o1;
#pragma unroll
    for (int r = 0; r < 16; ++r) { o0[r] = 0.f; o1[r] = 0.f; }
    float carry = 1.0f; bool done = false;
    const int NT = (q0 + 128) / 64;
    const int skey = (tid & 255) >> 2, sc = 2 * (tid & 3);
    const bf16* kg = K + (rowbase + skey) * DM + h * 64 + sc * 8; const bf16* vg = V + (rowbase + skey) * DM + h * 64 + sc * 8;
#define SBA_LOAD(TT) do { const size_t o_ = (size_t)(TT) * 64 * DM; kreg = *(const u32x4*)(kg + o_); kreg2 = *(const u32x4*)(kg + o_ + 8); vreg = *(const u32x4*)(vg + o_); vreg2 = *(const u32x4*)(vg + o_ + 8); } while (0)
    u32x4 kreg, kreg2, vreg, vreg2; SBA_LOAD(NT - 1);
#define SBA_STAGE(BUF) do { LAS unsigned char* bb_ = lds + (BUF) * BUF_BYTES; *(LAS u32x4*)(bb_ + KS_OFF + sc * 1024 + skey * 16) = kreg; *(LAS u32x4*)(bb_ + KS_OFF + (sc + 1) * 1024 + skey * 16) = kreg2; \
        *(LAS u32x4*)(bb_ + VT_OFF + skey * VT_PITCH + sc * 16) = vreg; *(LAS u32x4*)(bb_ + VT_OFF + skey * VT_PITCH + (sc + 1) * 16) = vreg2; } while (0)
    __syncthreads();
    SBA_STAGE(0);
    if (NT > 1) SBA_LOAD(NT - 2);
    __syncthreads();
    for (int t = NT - 1; t >= 0; --t) {
        const int cur = (NT - 1 - t) & 1;
        if (t > 0) SBA_STAGE(cur ^ 1);
        if (t > 1) SBA_LOAD(t - 2);
        if (!done && 64 * t <= qw0) {
            const LAS unsigned char* bb = lds + cur * BUF_BYTES;
            f32x16 p0, p1;
#pragma unroll
            for (int r = 0; r < 16; ++r) { p0[r] = 0.f; p1[r] = 0.f; }
            const LAS unsigned char* kb = bb + KS_OFF + hi * 1024 + r32 * 16;
#pragma unroll
            for (int d0 = 0; d0 < 4; ++d0) {
                const bf16x8 a0 = *(const LAS bf16x8*)(kb + d0 * 2048), a1 = *(const LAS bf16x8*)(kb + d0 * 2048 + 512);
                p0 = __builtin_amdgcn_mfma_f32_32x32x16_bf16(a0, qr[d0], p0, 0, 0, 0);
                p1 = __builtin_amdgcn_mfma_f32_32x32x16_bf16(a1, qr[d0], p1, 0, 0, 0);
            }
            const bool need_mask = (64 * t + 64 > qw0);
            const int qrel = qw0 + r32 - 64 * t;
            unsigned pw[16];
#pragma unroll
            for (int i = 7; i >= 0; --i) {
                const int half = i >> 2, rg = i & 3;
                f32x4 zv;
#pragma unroll
                for (int e = 0; e < 4; ++e) zv[e] = half ? p1[4 * rg + e] : p0[4 * rg + e];
                f32x4 ev;
#pragma unroll
                for (int e = 0; e < 4; ++e) ev[e] = __builtin_amdgcn_exp2f(-zv[e]);
                ev = ev + 1.0f;
                f32x4 bt;
#pragma unroll
                for (int e = 0; e < 4; ++e) bt[e] = __builtin_amdgcn_rcpf(ev[e]);
                if (need_mask) {
#pragma unroll
                    for (int e = 0; e < 4; ++e) { const int keyrel = 32 * half + 8 * rg + 4 * hi + e; if (keyrel >= qrel) bt[e] = 0.f; }
                }
                const f32x4 kp = 1.0f - bt;
                const float t3 = kp[3], t2 = t3 * kp[2], t1 = t2 * kp[1], tot = t1 * kp[0];
                const auto rr = __builtin_amdgcn_permlane32_swap(__float_as_uint(tot), __float_as_uint(tot), false, false);
                const float ta = __uint_as_float(rr[0]), tb = __uint_as_float(rr[1]);
                const float E = hi ? carry : carry * tb;
                carry = carry * (ta * tb);
                const f32x4 tv = {t1, t2, t3, 1.0f};
                const f32x4 pv = (bt * tv) * E;
                pw[2 * i] = cvt_pk(pv[0], pv[1]); pw[2 * i + 1] = cvt_pk(pv[2], pv[3]);
            }
            const LAS unsigned char* vb = bb + VT_OFF + (4 * hi + ((lane & 15) >> 2)) * VT_PITCH + (16 * ((lane >> 4) & 1) + 4 * (lane & 3)) * 2;
#pragma unroll
            for (int ks = 0; ks < 4; ++ks) {
                u32x4 bw; bw.x = pw[4 * ks]; bw.y = pw[4 * ks + 1]; bw.z = pw[4 * ks + 2]; bw.w = pw[4 * ks + 3];
                const bf16x8 bfrag = __builtin_bit_cast(bf16x8, bw);
#pragma unroll
                for (int dh = 0; dh < 2; ++dh) {
                    const v4i16_tr lo = __builtin_amdgcn_ds_read_tr16_b64_v4i16((LAS v4i16_tr*)(vb + (16 * ks) * VT_PITCH + dh * 64));
                    const v4i16_tr h2 = __builtin_amdgcn_ds_read_tr16_b64_v4i16((LAS v4i16_tr*)(vb + (16 * ks + 8) * VT_PITCH + dh * 64));
                    const bf16x8 afrag = (bf16x8){lo[0], lo[1], lo[2], lo[3], h2[0], h2[1], h2[2], h2[3]};
                    if (dh == 0) o0 = __builtin_amdgcn_mfma_f32_32x32x16_bf16(afrag, bfrag, o0, 0, 0, 0);
                    else o1 = __builtin_amdgcn_mfma_f32_32x32x16_bf16(afrag, bfrag, o1, 0, 0, 0);
                }
            }
            done = __all(carry == 0.0f);
        }
        if (lane == 0) *(LAS int*)(lds_all + FLAG_OFF + (cur * 8 + wid) * 4) = done ? 1 : 0;
        __syncthreads();
        { const u32x4 f0 = *(LAS u32x4*)(lds_all + FLAG_OFF + cur * 32), f1 = *(LAS u32x4*)(lds_all + FLAG_OFF + cur * 32 + 16);
          const unsigned alld = f0[0] & f0[1] & f0[2] & f0[3] & f1[0] & f1[1] & f1[2] & f1[3];
          if (__builtin_amdgcn_readfirstlane(alld) != 0u) break; }
    }
#undef SBA_STAGE
#undef SBA_LOAD
    bf16* op = O + (rowbase + qw0 + r32) * DM + h * 64 + 4 * hi;
#pragma unroll
    for (int rg = 0; rg < 4; ++rg) {
        u32x2 w0; w0.x = cvt_pk(o0[4 * rg], o0[4 * rg + 1]); w0.y = cvt_pk(o0[4 * rg + 2], o0[4 * rg + 3]); *(u32x2*)(op + 8 * rg) = w0;
        u32x2 w1; w1.x = cvt_pk(o1[4 * rg], o1[4 * rg + 1]); w1.y = cvt_pk(o1[4 * rg + 2], o1[4 * rg + 3]); *(u32x2*)(op + 32 + 8 * rg) = w1;
    }
}
__device__ __forceinline__ void phase(LAS unsigned char* lds, const bf16* Q, const bf16* K, const bf16* V, bf16* O) {
    for (int i = blockIdx.x; i < 1024; i += gridDim.x) {
        const int v = i & 255, rnd = i >> 8, bp = v >> 3, s = v & 7;
        const int qb = (rnd == 0) ? s : (rnd == 1) ? 15 - s : (rnd == 2) ? 16 + s : 31 - s;
        unit(lds, Q, K, V, O, bp >> 3, bp & 7, qb);
    }
}
}
namespace ssd {
constexpr int XN_OFF = 0, XN_PITCH = 528, BN_OFF = 128 * XN_PITCH, BN_PITCH = 272, CN_OFF = BN_OFF + 128 * BN_PITCH, DTV_OFF = CN_OFF + 128 * BN_PITCH, ACU_OFF = DTV_OFF + 2048, WTOT_OFF = ACU_OFF + 2048, S1_LDS = WTOT_OFF + 64;
static_assert(S1_LDS <= LDS_BYTES, "S1 LDS");
struct Bufs { const bf16* z; const bf16* xs_raw; const bf16* bc_raw; bf16* ypart; bf16* states; bf16* hprev; bf16* yn; bf16* cc; const float* dt_raw; float* acum; float* alast;
              const float* conv_w; const float* conv_b; const float* dt_bias; const float* a_log; const float* dsk; const float* ng; };

__device__ __forceinline__ u32x4 conv8(const bf16* src, size_t row, int tpos, int col, const float* cw, const float* cb, int cch) {
    float acc[8];
    { const f32x4 b0 = *(const f32x4*)(cb + cch), b1 = *(const f32x4*)(cb + cch + 4);
#pragma unroll
      for (int e = 0; e < 4; ++e) { acc[e] = b0[e]; acc[4 + e] = b1[e]; } }
#pragma unroll
    for (int k = 0; k < 4; ++k) {
        if (tpos - 3 + k >= 0) {
            const u32x4 raw = *(const u32x4*)(src + (row - 3 + k) * 2048 + col);
            const f32x4 w0 = *(const f32x4*)(cw + k * 4096 + cch), w1 = *(const f32x4*)(cw + k * 4096 + cch + 4);
            acc[0] += w0[0] * bf_lo(raw[0]); acc[1] += w0[1] * bf_hi(raw[0]); acc[2] += w0[2] * bf_lo(raw[1]); acc[3] += w0[3] * bf_hi(raw[1]);
            acc[4] += w1[0] * bf_lo(raw[2]); acc[5] += w1[1] * bf_hi(raw[2]); acc[6] += w1[2] * bf_lo(raw[3]); acc[7] += w1[3] * bf_hi(raw[3]);
        }
    }
    u32x4 o;
#pragma unroll
    for (int q = 0; q < 4; ++q) o[q] = cvt_pk(silu_f(acc[2 * q]), silu_f(acc[2 * q + 1]));
    return o;
}
typedef short v4i16_tr __attribute__((ext_vector_type(4)));
__device__ __forceinline__ bf16x8 tr8(const LAS unsigned char* p, int step_bytes) {
    const v4i16_tr lo = __builtin_amdgcn_ds_read_tr16_b64_v4i16((LAS v4i16_tr*)p), h2 = __builtin_amdgcn_ds_read_tr16_b64_v4i16((LAS v4i16_tr*)(p + step_bytes));
    return (bf16x8){lo[0], lo[1], lo[2], lo[3], h2[0], h2[1], h2[2], h2[3]};
}
__device__ __forceinline__ bf16x8 gather8(const LAS unsigned char* p, int pitch) {
    u32x4 w;
#pragma unroll
    for (int q = 0; q < 4; ++q) { const unsigned lo = *(const LAS unsigned short*)(p + (2 * q) * pitch), hh = *(const LAS unsigned short*)(p + (2 * q + 1) * pitch); w[q] = lo | (hh << 16); }
    return __builtin_bit_cast(bf16x8, w);
}

template <int NT> __device__ __forceinline__ void conv_load(u32x4 (&raw)[NT + 3], const bf16* src, size_t row0, int tpos0, int l0, int col) {
#pragma unroll
    for (int t = 0; t < NT + 3; ++t) { const int l = l0 - 3 + t; raw[t] = (u32x4){0u, 0u, 0u, 0u}; if (tpos0 + l >= 0) raw[t] = *(const u32x4*)(src + (row0 + l) * 2048 + col); }
}
template <int NT, class F> __device__ __forceinline__ void conv_compute(const u32x4 (&raw)[NT + 3], const float* cw, const float* cb, int cch, F out) {
    float w[4][8], bias[8];
#pragma unroll
    for (int k = 0; k < 4; ++k) { const f32x4 w0 = *(const f32x4*)(cw + k * 4096 + cch), w1 = *(const f32x4*)(cw + k * 4096 + cch + 4);
#pragma unroll
        for (int e = 0; e < 4; ++e) { w[k][e] = w0[e]; w[k][4 + e] = w1[e]; } }
    { const f32x4 b0 = *(const f32x4*)(cb + cch), b1 = *(const f32x4*)(cb + cch + 4);
#pragma unroll
      for (int e = 0; e < 4; ++e) { bias[e] = b0[e]; bias[4 + e] = b1[e]; } }
#pragma unroll
    for (int t = 0; t < NT; ++t) {
        float acc[8];
#pragma unroll
        for (int e = 0; e < 8; ++e) acc[e] = bias[e];
#pragma unroll
        for (int k = 0; k < 4; ++k) {
#pragma unroll
            for (int q = 0; q < 4; ++q) { acc[2 * q] += w[k][2 * q] * bf_lo(raw[t + k][q]); acc[2 * q + 1] += w[k][2 * q + 1] * bf_hi(raw[t + k][q]); }
        }
        u32x4 o;
#pragma unroll
        for (int q = 0; q < 4; ++q) o[q] = cvt_pk(silu_f(acc[2 * q]), silu_f(acc[2 * q + 1]));
        out(t, o);
    }
}

__device__ __forceinline__ void s1_item(LAS unsigned char* lds, const Bufs& B, int item) {
    const int tid = tid_l(), lane = tid & 63, r32 = lane & 31, hi = lane >> 5; const int wid = __builtin_amdgcn_readfirstlane(tid >> 6);
    const int g = item & 7, c = (item >> 3) & 31, b = item >> 8;
    const size_t row0 = (size_t)b * SEQ + c * 128; const int tpos0 = c * 128;
    const float dt_in = B.dt_raw[(row0 + (tid & 127)) * 32 + 4 * g + (tid >> 7)] + B.dt_bias[4 * g + (tid >> 7)], alog_in = B.a_log[4 * g + (tid >> 7)];
    __syncthreads();
    { const int c8x = tid & 31, l0x = 8 * (tid >> 5), c8 = tid & 15, l0 = 4 * (tid >> 4);
      u32x4 rx[11], rb[7], rc[7];
      conv_load<8>(rx, B.xs_raw, row0, tpos0, l0x, 256 * g + 8 * c8x);
      conv_load<4>(rb, B.bc_raw, row0, tpos0, l0, 128 * g + 8 * c8);
      conv_load<4>(rc, B.bc_raw, row0, tpos0, l0, 1024 + 128 * g + 8 * c8);
      conv_compute<8>(rx, B.conv_w, B.conv_b, 256 * g + 8 * c8x, [&](int t, u32x4 v) { *(LAS u32x4*)(lds + XN_OFF + (l0x + t) * XN_PITCH + c8x * 16) = v; });
      conv_compute<4>(rb, B.conv_w, B.conv_b, 2048 + 128 * g + 8 * c8, [&](int t, u32x4 v) { *(LAS u32x4*)(lds + BN_OFF + (l0 + t) * BN_PITCH + c8 * 16) = v; });
      conv_compute<4>(rc, B.conv_w, B.conv_b, 3072 + 128 * g + 8 * c8, [&](int t, u32x4 v) { *(LAS u32x4*)(lds + CN_OFF + (l0 + t) * BN_PITCH + c8 * 16) = v;
          *(u32x4*)(B.cc + (row0 + l0 + t) * 1024 + 128 * g + 8 * c8) = v; }); }
    float dtv, scan;
    { const int r = tid >> 7, l = tid & 127, hh = 4 * g + r;
      const float x = dt_in;
      dtv = (x > 20.f) ? x : log1pf(__expf(x));
      const float av = -__expf(alog_in);
      scan = dtv * av;
#pragma unroll
      for (int o = 1; o < 64; o <<= 1) { const float v = __shfl_up(scan, o); if (lane >= o) scan += v; }
      if (lane == 63) *(LAS float*)(lds + WTOT_OFF + wid * 4) = scan; }
    __syncthreads();
    { const int r = tid >> 7, l = tid & 127, hh = 4 * g + r;
      if (l >= 64) scan += *(LAS float*)(lds + WTOT_OFF + (wid - 1) * 4);
      *(LAS float*)(lds + ACU_OFF + (r * 128 + l) * 4) = scan; *(LAS float*)(lds + DTV_OFF + (r * 128 + l) * 4) = dtv;
      B.acum[(row0 + l) * 32 + hh] = scan;
      if (l == 127) B.alast[(b * NCHUNK + c) * 32 + hh] = scan; }
    __syncthreads();
    {
        const int r = wid >> 1, pb = wid & 1, head = 4 * g + r;
        const float al = *(const LAS float*)(lds + ACU_OFF + (r * 128 + 127) * 4);
        bf16x8 xa[8];
#pragma unroll
        for (int ks = 0; ks < 8; ++ks) {
            const int s0 = 16 * ks + 8 * hi;
            const f32x4 a0 = *(const LAS f32x4*)(lds + ACU_OFF + (r * 128 + s0) * 4), a1 = *(const LAS f32x4*)(lds + ACU_OFF + (r * 128 + s0 + 4) * 4);
            const f32x4 d0 = *(const LAS f32x4*)(lds + DTV_OFF + (r * 128 + s0) * 4), d1 = *(const LAS f32x4*)(lds + DTV_OFF + (r * 128 + s0 + 4) * 4);
            const bf16x8 xr8 = tr8(lds + XN_OFF + (s0 + ((lane & 15) >> 2)) * XN_PITCH + (64 * r + 32 * pb + 16 * ((lane >> 4) & 1) + 4 * (lane & 3)) * 2, 4 * XN_PITCH);
            float v[8];
#pragma unroll
            for (int j = 0; j < 8; ++j) { const float te = __expf(al - (j < 4 ? a0[j & 3] : a1[j & 3])) * (j < 4 ? d0[j & 3] : d1[j & 3]); v[j] = bf_us((unsigned short)xr8[j]) * te; }
            u32x4 w; w.x = cvt_pk(v[0], v[1]); w.y = cvt_pk(v[2], v[3]); w.z = cvt_pk(v[4], v[5]); w.w = cvt_pk(v[6], v[7]);
            xa[ks] = __builtin_bit_cast(bf16x8, w);
        }
        bf16* sp = B.states + ((((size_t)b * NCHUNK + c) * 32 + head) * 64 + 32 * pb + r32) * 128 + 4 * hi;
#pragma unroll 1
        for (int nb = 0; nb < 4; ++nb) {
            f32x16 st;
#pragma unroll
            for (int q = 0; q < 16; ++q) st[q] = 0.f;
#pragma unroll
            for (int ks = 0; ks < 8; ++ks) {
                const bf16x8 af = tr8(lds + BN_OFF + (16 * ks + 8 * hi + ((lane & 15) >> 2)) * BN_PITCH + (32 * nb + 16 * ((lane >> 4) & 1) + 4 * (lane & 3)) * 2, 4 * BN_PITCH);
                st = __builtin_amdgcn_mfma_f32_32x32x16_bf16(af, xa[ks], st, 0, 0, 0);
            }
#pragma unroll
            for (int rg = 0; rg < 4; ++rg) { u32x2 w; w.x = cvt_pk(st[4 * rg], st[4 * rg + 1]); w.y = cvt_pk(st[4 * rg + 2], st[4 * rg + 3]); *(u32x2*)(sp + 32 * nb + 8 * rg) = w; }
        }
    }
    const int lb = wid & 3, hp = wid >> 2, l = 32 * lb + r32;
    f32x16 yv[2][2];
    {
        bf16x8 cf[8];
#pragma unroll
        for (int k = 0; k < 8; ++k) cf[k] = *(const LAS bf16x8*)(lds + CN_OFF + l * BN_PITCH + (16 * k + 8 * hi) * 2);
        f32x16 cb[4];
#pragma unroll
        for (int sb = 0; sb < 4; ++sb) {
#pragma unroll
            for (int r = 0; r < 16; ++r) cb[sb][r] = 0.f;
            if (sb <= lb) {
#pragma unroll
                for (int k = 0; k < 8; ++k) { const bf16x8 af = *(const LAS bf16x8*)(lds + BN_OFF + (32 * sb + r32) * BN_PITCH + (16 * k + 8 * hi) * 2);
                    cb[sb] = __builtin_amdgcn_mfma_f32_32x32x16_bf16(af, cf[k], cb[sb], 0, 0, 0); }
            }
        }
#pragma unroll
        for (int hh = 0; hh < 2; ++hh) {
            const int r = 2 * hp + hh, head = 4 * g + r;
            const float acl = *(const LAS float*)(lds + ACU_OFF + (r * 128 + l) * 4);
            const float dsk = B.dsk[head];
            f32x16 y0, y1;
#pragma unroll
            for (int q = 0; q < 16; ++q) { y0[q] = 0.f; y1[q] = 0.f; }
#pragma unroll
            for (int sb = 0; sb < 4; ++sb) {
                if (sb <= lb) {
                    unsigned pwv[8];
#pragma unroll
                    for (int rg = 0; rg < 4; ++rg) {
                        const int sl = 32 * sb + 8 * rg + 4 * hi;
                        const f32x4 as4 = *(const LAS f32x4*)(lds + ACU_OFF + (r * 128 + sl) * 4), dt4 = *(const LAS f32x4*)(lds + DTV_OFF + (r * 128 + sl) * 4);
                        float w[4];
#pragma unroll
                        for (int e = 0; e < 4; ++e) { float v = cb[sb][4 * rg + e] * __expf(acl - as4[e]) * dt4[e]; if (sl + e > l) v = 0.f; if (sl + e == l) v += dsk; w[e] = v; }
                        pwv[2 * rg] = cvt_pk(w[0], w[1]); pwv[2 * rg + 1] = cvt_pk(w[2], w[3]);
                    }
#pragma unroll
                    for (int ks = 0; ks < 2; ++ks) {
                        u32x4 bw; bw.x = pwv[4 * ks]; bw.y = pwv[4 * ks + 1]; bw.z = pwv[4 * ks + 2]; bw.w = pwv[4 * ks + 3];
                        const bf16x8 bfrag = __builtin_bit_cast(bf16x8, bw);
                        const LAS unsigned char* xq = lds + XN_OFF + (32 * sb + 16 * ks + 4 * hi + ((lane & 15) >> 2)) * XN_PITCH + (64 * r + 16 * ((lane >> 4) & 1) + 4 * (lane & 3)) * 2;
#pragma unroll
                        for (int pb = 0; pb < 2; ++pb) {
                            const bf16x8 afrag = tr8(xq + pb * 64, 8 * XN_PITCH);
                            if (pb == 0) y0 = __builtin_amdgcn_mfma_f32_32x32x16_bf16(afrag, bfrag, y0, 0, 0, 0);
                            else y1 = __builtin_amdgcn_mfma_f32_32x32x16_bf16(afrag, bfrag, y1, 0, 0, 0);
                        }
                    }
                }
            }
            yv[hh][0] = y0; yv[hh][1] = y1;
        }
    }
    __syncthreads();
#pragma unroll
    for (int hh = 0; hh < 2; ++hh)
#pragma unroll
        for (int pb = 0; pb < 2; ++pb) {
            LAS unsigned char* yl = lds + XN_OFF + l * XN_PITCH + (64 * (2 * hp + hh) + 32 * pb + 4 * hi) * 2;
#pragma unroll
            for (int rg = 0; rg < 4; ++rg) { u32x2 w; w.x = cvt_pk(yv[hh][pb][4 * rg], yv[hh][pb][4 * rg + 1]); w.y = cvt_pk(yv[hh][pb][4 * rg + 2], yv[hh][pb][4 * rg + 3]); *(LAS u32x2*)(yl + 16 * rg) = w; }
        }
    __syncthreads();
#pragma unroll 4
    for (int i = 0; i < 8; ++i) { const int idx = tid + 512 * i, ll = idx >> 5, c8 = idx & 31;
        *(u32x4*)(B.ypart + (row0 + ll) * 2048 + 256 * g + 8 * c8) = *(const LAS u32x4*)(lds + XN_OFF + ll * XN_PITCH + c8 * 16); }
}

__device__ __forceinline__ void s2_phase(const Bufs& B) {
    const int nthr = gridDim.x * 512;
    for (int idx = blockIdx.x * 512 + tid_l(); idx < NB * 32 * 64 * 16; idx += nthr) {
        const int n8 = idx & 15, p = (idx >> 4) & 63, head = (idx >> 10) & 31, b = idx >> 15;
        float hacc[8];
#pragma unroll
        for (int e = 0; e < 8; ++e) hacc[e] = 0.f;
        const size_t base = (((size_t)b * NCHUNK) * 32 + head) * 8192 + p * 128 + 8 * n8;
        u32x4 nxt = *(const u32x4*)(B.states + base);
#pragma unroll 4
        for (int c = 0; c < NCHUNK; ++c) {
            const size_t off = base + (size_t)c * 32 * 8192;
            const u32x4 st = nxt;
            if (c + 1 < NCHUNK) nxt = *(const u32x4*)(B.states + off + (size_t)32 * 8192);
            u32x4 o;
#pragma unroll
            for (int q = 0; q < 4; ++q) o[q] = cvt_pk(hacc[2 * q], hacc[2 * q + 1]);
            *(u32x4*)(B.hprev + off) = o;
            const float dec = __expf(B.alast[(b * NCHUNK + c) * 32 + head]);
#pragma unroll
            for (int q = 0; q < 4; ++q) { hacc[2 * q] = hacc[2 * q] * dec + bf_lo(st[q]); hacc[2 * q + 1] = hacc[2 * q + 1] * dec + bf_hi(st[q]); }
        }
    }
}

constexpr int S3_Y = 0, S3_Z = 128 * XN_PITCH, S3_TAB = 2 * 128 * XN_PITCH;
__device__ __forceinline__ void s3_item(LAS unsigned char* lds, const Bufs& B, int item) {
    const int tid = tid_l(), lane = tid & 63, r32 = lane & 31, hi = lane >> 5; const int wid = __builtin_amdgcn_readfirstlane(tid >> 6);
    const int g = item & 7, c = (item >> 3) & 31, b = item >> 8;
    const int lb = wid & 3, hp = wid >> 2, l = 32 * lb + r32;
    const size_t row0 = (size_t)b * SEQ + c * 128, row = row0 + l;
    __syncthreads();
#pragma unroll 4
    for (int i = 0; i < 8; ++i) { const int idx = tid + 512 * i, ll = idx >> 5, c8 = idx & 31; const size_t off = (row0 + ll) * 2048 + 256 * g + 8 * c8;
        *(LAS u32x4*)(lds + S3_Y + ll * XN_PITCH + c8 * 16) = *(const u32x4*)(B.ypart + off);
        *(LAS u32x4*)(lds + S3_Z + ll * XN_PITCH + c8 * 16) = *(const u32x4*)(B.z + off); }
    bf16x8 cf[8];
#pragma unroll
    for (int k = 0; k < 8; ++k) cf[k] = *(const bf16x8*)(B.cc + row * 1024 + 128 * g + 16 * k + 8 * hi);
    const float ac0 = B.acum[row * 32 + 4 * g + 2 * hp], ac1 = B.acum[row * 32 + 4 * g + 2 * hp + 1];
    f32x16 y[2][2];
#pragma unroll
    for (int hh = 0; hh < 2; ++hh) {
        const int head = 4 * g + 2 * hp + hh;
        const bf16* hb = B.hprev + (((size_t)b * NCHUNK + c) * 32 + head) * 8192 + (size_t)r32 * 128 + 8 * hi;
#pragma unroll
        for (int pb = 0; pb < 2; ++pb) {
            f32x16 acc;
#pragma unroll
            for (int q = 0; q < 16; ++q) acc[q] = 0.f;
#pragma unroll
            for (int k = 0; k < 8; ++k) { const bf16x8 af = *(const bf16x8*)(hb + pb * 32 * 128 + 16 * k); acc = __builtin_amdgcn_mfma_f32_32x32x16_bf16(af, cf[k], acc, 0, 0, 0); }
            y[hh][pb] = acc;
        }
    }
    __syncthreads();
    float ss = 0.f;
#pragma unroll
    for (int hh = 0; hh < 2; ++hh) {
        const int r = 2 * hp + hh;
        const float ea = __expf(hh ? ac1 : ac0);
#pragma unroll
        for (int pb = 0; pb < 2; ++pb) {
            const int cl = 64 * r + 32 * pb + 4 * hi;
#pragma unroll
            for (int rg = 0; rg < 4; ++rg) {
                const u32x2 yp = *(const LAS u32x2*)(lds + S3_Y + l * XN_PITCH + (cl + 8 * rg) * 2), zz = *(const LAS u32x2*)(lds + S3_Z + l * XN_PITCH + (cl + 8 * rg) * 2);
                const float v0 = (bf_lo(yp.x) + ea * y[hh][pb][4 * rg]) * silu_f(bf_lo(zz.x)), v1 = (bf_hi(yp.x) + ea * y[hh][pb][4 * rg + 1]) * silu_f(bf_hi(zz.x));
                const float v2 = (bf_lo(yp.y) + ea * y[hh][pb][4 * rg + 2]) * silu_f(bf_lo(zz.y)), v3 = (bf_hi(yp.y) + ea * y[hh][pb][4 * rg + 3]) * silu_f(bf_hi(zz.y));
                y[hh][pb][4 * rg] = v0; y[hh][pb][4 * rg + 1] = v1; y[hh][pb][4 * rg + 2] = v2; y[hh][pb][4 * rg + 3] = v3;
                ss += (v0 * v0 + v1 * v1) + (v2 * v2 + v3 * v3);
            }
        }
    }
    ss += __shfl_xor(ss, 32);
    if (hi == 0) *(LAS float*)(lds + S3_TAB + (wid * 32 + r32) * 4) = ss;
    __syncthreads();
    const float tot = *(const LAS float*)(lds + S3_TAB + (wid * 32 + r32) * 4) + *(const LAS float*)(lds + S3_TAB + ((wid ^ 4) * 32 + r32) * 4);
    const float rs = rsqrtf(tot * (1.0f / 256.0f) + RMS_EPS);
#pragma unroll
    for (int hh = 0; hh < 2; ++hh)
#pragma unroll
        for (int pb = 0; pb < 2; ++pb) {
            const int cl = 64 * (2 * hp + hh) + 32 * pb + 4 * hi;
#pragma unroll
            for (int rg = 0; rg < 4; ++rg) {
                const f32x4 gg = *(const f32x4*)(B.ng + 256 * g + cl + 8 * rg);
                u32x2 w; w.x = cvt_pk(y[hh][pb][4 * rg] * rs * gg[0], y[hh][pb][4 * rg + 1] * rs * gg[1]); w.y = cvt_pk(y[hh][pb][4 * rg + 2] * rs * gg[2], y[hh][pb][4 * rg + 3] * rs * gg[3]);
                *(LAS u32x2*)(lds + S3_Y + l * XN_PITCH + (cl + 8 * rg) * 2) = w;
            }
        }
    __syncthreads();
#pragma unroll 4
    for (int i = 0; i < 8; ++i) { const int idx = tid + 512 * i, ll = idx >> 5, c8 = idx & 31;
        *(u32x4*)(B.yn + (row0 + ll) * 2048 + 256 * g + 8 * c8) = *(const LAS u32x4*)(lds + S3_Y + ll * XN_PITCH + c8 * 16); }
}
constexpr int S3W_PITCH = 144, S3W_TILE = 32 * S3W_PITCH, S3W_BYTES = 2 * S3W_TILE;
__device__ __forceinline__ void s3_wave_item(LAS unsigned char* wl, const Bufs& B, int witem, int lane) {
    const int r32 = lane & 31, hi = lane >> 5;
    const int lb = witem & 3, g = (witem >> 2) & 7, c = (witem >> 5) & 31, b = witem >> 10;
    const size_t row0 = (size_t)b * SEQ + c * 128 + 32 * lb, row = row0 + r32;
    LAS unsigned char* Yt = wl; LAS unsigned char* Zt = wl + S3W_TILE;
    bf16x8 cf[8];
#pragma unroll
    for (int k = 0; k < 8; ++k) cf[k] = *(const bf16x8*)(B.cc + row * 1024 + 128 * g + 16 * k + 8 * hi);
    const f32x4 ac4 = *(const f32x4*)(B.acum + row * 32 + 4 * g);
    unsigned yk[4][2][8]; float ss = 0.f;
    const int srow = lane >> 3, sch = lane & 7;
#pragma unroll
    for (int r = 0; r < 4; ++r) {
        const int head = 4 * g + r;
        const bf16* hb = B.hprev + (((size_t)b * NCHUNK + c) * 32 + head) * 8192 + (size_t)r32 * 128 + 8 * hi;
        u32x4 yl[4], zl[4];
#pragma unroll
        for (int i = 0; i < 4; ++i) { const size_t off = (row0 + srow + 8 * i) * 2048 + 256 * g + 64 * r + 8 * sch; yl[i] = *(const u32x4*)(B.ypart + off); zl[i] = *(const u32x4*)(B.z + off); }
        f32x16 accs[2];
#pragma unroll
        for (int pb = 0; pb < 2; ++pb) {
            f32x16 acc;
#pragma unroll
            for (int q = 0; q < 16; ++q) acc[q] = 0.f;
#pragma unroll
            for (int k = 0; k < 8; ++k) { const bf16x8 af = *(const bf16x8*)(hb + pb * 32 * 128 + 16 * k); acc = __builtin_amdgcn_mfma_f32_32x32x16_bf16(af, cf[k], acc, 0, 0, 0); }
            accs[pb] = acc;
        }
#pragma unroll
        for (int i = 0; i < 4; ++i) { *(LAS u32x4*)(Yt + (srow + 8 * i) * S3W_PITCH + sch * 16) = yl[i]; *(LAS u32x4*)(Zt + (srow + 8 * i) * S3W_PITCH + sch * 16) = zl[i]; }
        asm volatile("" ::: "memory");
        const float ea = __expf(ac4[r]);
#pragma unroll
        for (int pb = 0; pb < 2; ++pb)
#pragma unroll
            for (int rg = 0; rg < 4; ++rg) {
                const int cl = 32 * pb + 8 * rg + 4 * hi;
                const u32x2 yp = *(const LAS u32x2*)(Yt + r32 * S3W_PITCH + cl * 2), zz = *(const LAS u32x2*)(Zt + r32 * S3W_PITCH + cl * 2);
                const float v0 = (bf_lo(yp.x) + ea * accs[pb][4 * rg]) * silu_f(bf_lo(zz.x)), v1 = (bf_hi(yp.x) + ea * accs[pb][4 * rg + 1]) * silu_f(bf_hi(zz.x));
                const float v2 = (bf_lo(yp.y) + ea * accs[pb][4 * rg + 2]) * silu_f(bf_lo(zz.y)), v3 = (bf_hi(yp.y) + ea * accs[pb][4 * rg + 3]) * silu_f(bf_hi(zz.y));
                yk[r][pb][2 * rg] = cvt_pk(v0, v1); yk[r][pb][2 * rg + 1] = cvt_pk(v2, v3);
                ss += (v0 * v0 + v1 * v1) + (v2 * v2 + v3 * v3);
            }
        asm volatile("" ::: "memory");
    }
    ss += __shfl_xor(ss, 32);
    const float rs = rsqrtf(ss * (1.0f / 256.0f) + RMS_EPS);
#pragma unroll
    for (int r = 0; r < 4; ++r) {
        asm volatile("" ::: "memory");
#pragma unroll
        for (int pb = 0; pb < 2; ++pb)
#pragma unroll
            for (int rg = 0; rg < 4; ++rg) {
                const int cl = 32 * pb + 8 * rg + 4 * hi;
                const f32x4 gg = *(const f32x4*)(B.ng + 256 * g + 64 * r + cl);
                const unsigned p0 = yk[r][pb][2 * rg], p1 = yk[r][pb][2 * rg + 1];
                u32x2 w; w.x = cvt_pk(bf_lo(p0) * rs * gg[0], bf_hi(p0) * rs * gg[1]); w.y = cvt_pk(bf_lo(p1) * rs * gg[2], bf_hi(p1) * rs * gg[3]);
                *(LAS u32x2*)(Yt + r32 * S3W_PITCH + cl * 2) = w;
            }
        asm volatile("" ::: "memory");
#pragma unroll
        for (int i = 0; i < 4; ++i) *(u32x4*)(B.yn + (row0 + srow + 8 * i) * 2048 + 256 * g + 64 * r + 8 * sch) = *(const LAS u32x4*)(Yt + (srow + 8 * i) * S3W_PITCH + sch * 16);
    }
}
__device__ __forceinline__ void s3_phase(LAS unsigned char* lds, const Bufs& B) {
    const int tid = tid_l(), lane = tid & 63; const int wid = __builtin_amdgcn_readfirstlane(tid >> 6);
    LAS unsigned char* wl = lds + wid * S3W_BYTES;
    for (int wit = blockIdx.x * 8 + wid; wit < NB * NCHUNK * 8 * 4; wit += gridDim.x * 8) s3_wave_item(wl, B, wit, lane);
}
}
#define XB_TMO      128
#define XB_XCNT(j)  (256  + 64 * (j))
#define XB_XSUB(j)  (1280 + 64 * (j))
#define XB_XGEN(j)  (2304 + 64 * (j))
#define XB_TOP      3328
#define XB_TOPGEN   3392
#define XCD_BAR_WORDS 3456
#define XB_SPIN_CAP (1u << 18)

__device__ __forceinline__ unsigned xb_ld(unsigned* p)              { return __hip_atomic_load(p, __ATOMIC_RELAXED, __HIP_MEMORY_SCOPE_AGENT); }
__device__ __forceinline__ unsigned xb_add(unsigned* p, unsigned v) { return __hip_atomic_fetch_add(p, v, __ATOMIC_RELAXED, __HIP_MEMORY_SCOPE_AGENT); }
__device__ __forceinline__ unsigned xb_xcc_id() { return (unsigned)__builtin_amdgcn_s_getreg((3 << 11) | 20) & 0xFu; }
#define XB_SPIN(cond, bar) do { unsigned _sp = 0; while (cond) { __builtin_amdgcn_s_sleep(1); \
    if ((++_sp & 255u) == 0u) { if (xb_ld(&(bar)[XB_TMO])) break; if (_sp > XB_SPIN_CAP) { atomicAdd(&(bar)[XB_TMO], 1u); break; } } } } while (0)

struct XcdBarrier {
    unsigned* bar; unsigned x;
    volatile LAS unsigned* st;
};

__device__ __forceinline__ XcdBarrier xcd_barrier_post(unsigned* bar, volatile LAS unsigned* st) {
    XcdBarrier b; b.bar = bar; b.x = xb_xcc_id(); b.st = st;
    if (threadIdx.x == 0) (void)xb_add(&bar[XB_XCNT(b.x)], 1u);
    return b;
}
__device__ __forceinline__ void xcd_barrier_complete(unsigned* bar, unsigned x, unsigned& nloc, unsigned& nx) {
    const unsigned G = gridDim.x * gridDim.y * gridDim.z;
    unsigned sum, cnt, mine, sp = 0u;
    for (;;) {
        sum = 0u; cnt = 0u; mine = 0u;
#pragma unroll
        for (unsigned j = 0; j < 16; ++j) { const unsigned c = xb_ld(&bar[XB_XCNT(j)]); sum += c; cnt += (c > 0u) ? 1u : 0u; mine = (j == x) ? c : mine; }
        if (sum == G) break;
        __builtin_amdgcn_s_sleep(1);
        if ((++sp & 255u) == 0u) { if (xb_ld(&bar[XB_TMO])) break; if (sp > XB_SPIN_CAP) { atomicAdd(&bar[XB_TMO], 1u); break; } }
    }
    nloc = mine > 0u ? mine : 1u; nx = cnt > 0u ? cnt : 1u;
}

__device__ __forceinline__ void xcd_barrier(const XcdBarrier& b) {
    asm volatile("s_waitcnt vmcnt(0)" ::: "memory");
    __syncthreads();
    if (threadIdx.x == 0) {
        unsigned* bar = b.bar;
        __builtin_amdgcn_s_waitcnt(0);
        unsigned nloc = b.st[0], nx = b.st[1];
        if (nloc == 0u) { xcd_barrier_complete(bar, b.x, nloc, nx); b.st[0] = nloc; b.st[1] = nx; }
        const unsigned old = xb_add(&bar[XB_XSUB(b.x)], 1u);
        const unsigned gen = old / nloc;
        if (old + 1u == (gen + 1u) * nloc) {
            __builtin_amdgcn_fence(__ATOMIC_RELEASE, "agent");
            asm volatile("s_waitcnt vmcnt(0)" ::: "memory");
            const unsigned og = xb_add(&bar[XB_TOP], 1u);
            const unsigned tg = og / nx;
            if (og + 1u == (tg + 1u) * nx) xb_add(&bar[XB_TOPGEN], 1u);
            else XB_SPIN(xb_ld(&bar[XB_TOPGEN]) == tg, bar);
            __builtin_amdgcn_fence(__ATOMIC_ACQUIRE, "agent");
            xb_add(&bar[XB_XGEN(b.x)], 1u);
            asm volatile("s_waitcnt vmcnt(0)" ::: "memory");
        } else {
            XB_SPIN(xb_ld(&bar[XB_XGEN(b.x)]) == gen, bar);
            __builtin_amdgcn_fence(__ATOMIC_ACQUIRE, "agent");
            asm volatile("s_waitcnt vmcnt(0)" ::: "memory");
        }
    }
    __syncthreads();
}


__global__ void __launch_bounds__(512, 2) hybrid_fwd(Args a) {
    extern __shared__ __attribute__((aligned(16))) unsigned char lds_raw[];
    LAS unsigned char* lds = (LAS unsigned char*)lds_raw;
    cg::grid_group grid = cg::this_grid();
    volatile LAS unsigned* bst = (volatile LAS unsigned*)(lds + LDS_BYTES - 16);
    { const ArgsP a0 = get_args(); unsigned* bw = (unsigned*)(a0->ws + WS_BAR);
      if (tid_l() < 2) bst[tid_l()] = 0u;
      if (tid_l() == 0) (void)xb_add(bw + XB_XCNT(xb_xcc_id()), 1u);
      if (a0->ws == nullptr) grid.sync(); }
#define XSYNC() do { XcdBarrier xbar_; xbar_.bar = (unsigned*)(get_args()->ws + WS_BAR); xbar_.x = xb_xcc_id(); xbar_.st = bst; xcd_barrier(xbar_); } while (0)
#define GRID_SYNC() do { asm volatile("s_waitcnt vmcnt(0) lgkmcnt(0)" ::: "memory"); grid.sync(); __builtin_amdgcn_fence(__ATOMIC_ACQUIRE, "agent"); asm volatile("s_waitcnt vmcnt(0)" ::: "memory"); } while (0)
#define TAIL_CONVERT(NWG, LYR, MASK) do { const int rem_ = (NWG) % G; if (rem_ == 0) convert_layer(get_args(), (LYR), lds, (MASK), bx, G); else if (bx >= rem_) convert_layer(get_args(), (LYR), lds, (MASK), bx - rem_, G - rem_); } while (0)
#pragma unroll 1
    for (int step = 0; step < MAXSTEP; ++step) {
        const int layer = step >> 3, k = step & 7, kind = layer % 3;
        if (k == 0 && layer > 0) continue;
        const ArgsP a = get_args();
        unsigned char* ws = a->ws; float* rsp = (float*)(ws + WS_RSP); bf16* xb = (bf16*)(ws + WS_XB); bf16* ar = (bf16*)(ws + WS_AR);
        const int G = gridDim.x, bx = blockIdx.x;
#ifdef REPEAT_MASK
        const int nrep = (((REPEAT_MASK >> k) & 1) && !(k == 4 && kind == 1)) ? 2 : 1;
#else
        const int nrep = 1;
#endif
#pragma unroll 1
        for (int rep = 0; rep < nrep; ++rep) {
        const float alpha_mul = (rep + 1 == nrep) ? 1.0f : 0.0f;
        if (k == 0) {
#if !defined(NO_P0)
            if (layer == 0) init_rows(a);
            convert_layer(a, layer, lds, 63, bx, G);
#endif
        } else if (k == 1 || k == 6) {
            pg8::Gemm g{xb, (const bf16*)(ws + (k == 1 ? W_GU1 : W_GU2)), T, 2 * FF, DM}; pg8::StaticOrder S; S.init(T, 2 * FF, G, bx);
            pg8::EpiSwiGLU E{ar, rsp, FF};
#if !defined(NO_G1)
            pg8::gemm_phase<pg8::EpiSwiGLU, pg8::StaticOrder, true, true>(lds, g, S, E);
#endif
            if (k == 1 && layer > 0) TAIL_CONVERT((T / 256) * (2 * FF / 256), layer, 2 | 8);
            if (k == 6 && layer + 1 < DEPTH) TAIL_CONVERT((T / 256) * (2 * FF / 256), layer + 1, (kind == 1) ? (16 | 32) : (1 | 4 | 16 | 32));
        } else if (k == 2 || k == 7) {
            pg8::Gemm g{ar, (const bf16*)(ws + (k == 2 ? W_D1 : W_D2)), T, DM, FF}; pg8::StaticOrder S; S.init(T, DM, G, bx);
            pg8::EpiResid E{xb, rsp, 0.5f * alpha_mul};
#if !defined(NO_G2)
            pg8::gemm_phase<pg8::EpiResid, pg8::StaticOrder, true, true>(lds, g, S, E);
#endif
        } else if (k == 3) {
            const int n = (kind == 1) ? SSD_IN_PAD : 3 * DM;
            pg8::Gemm g{xb, (const bf16*)(ws + W_IN), T, n, DM}; pg8::StaticOrder S; S.init(T, n, G, bx);
            pg8::EpiSplit E;
            if (kind == 1) E = pg8::EpiSplit{ar, 2048, 8, (size_t)T * 2048, rsp, 1.0f, (float*)(ws + WS_DT), 24};
            else E = pg8::EpiSplit{ar, 1024, 4, (size_t)T * 1024, rsp, (kind == 0) ? SB_C2 : 1.0f, nullptr, -1};
#if !defined(NO_G3)
            pg8::gemm_phase<pg8::EpiSplit, pg8::StaticOrder, true, true>(lds, g, S, E);
#endif
            if (kind == 1 && layer + 1 < DEPTH) TAIL_CONVERT((T / 256) * (SSD_IN_PAD / 256), layer + 1, 1 | 4);
        } else if (k == 4) {
            if (kind == 0) {
#if !defined(NO_SBA)
                sba::phase(lds, ar, ar + (size_t)T * 1024, ar + (size_t)2 * T * 1024, ar + (size_t)3 * T * 1024);
#endif
            } else if (kind == 1) {
                ssd::Bufs B;
                B.z = ar; B.xs_raw = ar + (size_t)T * 2048; B.bc_raw = ar + (size_t)2 * T * 2048; B.ypart = ar + (size_t)3 * T * 2048; B.states = ar + (size_t)4 * T * 2048;
                B.hprev = ar + (size_t)T * 2048; B.yn = ar + (size_t)4 * T * 2048; B.cc = (bf16*)a->out;
                B.dt_raw = (const float*)(ws + WS_DT); B.acum = (float*)(ws + WS_ACUM); B.alast = (float*)(ws + WS_ALAST);
                B.conv_w = a->in[11]; B.conv_b = a->in[12]; B.dt_bias = a->in[13]; B.a_log = a->in[14]; B.dsk = a->in[15]; B.ng = a->in[16];
#if !defined(NO_S1)
                for (int it = bx; it < NB * NCHUNK * 8; it += G) ssd::s1_item(lds, B, it);
#endif
                XSYNC();
#if !defined(NO_S2)
                ssd::s2_phase(B);
#endif
                XSYNC();
#if !defined(NO_S3)
                ssd::s3_phase(lds, B);
#endif
            } else {
#if !defined(NO_SC)
                shortconv_phase(ar, ar + (size_t)T * 1024, ar + (size_t)2 * T * 1024, a->in[19] + (size_t)(layer / 3) * 3 * DM, ar + (size_t)3 * T * 1024);
#endif
            }
        } else {
            const int kk = (kind == 1) ? 2 * DM : DM;
#ifdef DBG_AZ
            const bf16* A = (kind == 1) ? ar + (size_t)DBG_AZ * T * 2048 : ar + (size_t)3 * T * 1024;
#else
            const bf16* A = (kind == 1) ? ar + (size_t)4 * T * 2048 : ar + (size_t)3 * T * 1024;
#endif
            pg8::Gemm g{A, (const bf16*)(ws + W_OUT), T, DM, kk}; pg8::StaticOrder S; S.init(T, DM, G, bx);
            pg8::EpiResid E{xb, rsp, alpha_mul};
#if !defined(NO_G4)
            pg8::gemm_phase<pg8::EpiResid, pg8::StaticOrder, true, true>(lds, g, S, E);
#endif
        }
        XSYNC();
#ifdef REPEAT_SYNC
        XSYNC();
#endif
        }
    }
    final_norm(get_args());
}

extern "C" void kernel_launch(void* const* d_in, const int* in_sizes, int n_in, void* d_out, int out_size, void* d_ws, size_t ws_size, hipStream_t stream) {
    static int grid = 0;
    if (grid == 0) {
        if (n_in != 22 || out_size != T * DM || ws_size < WS_END) { fprintf(stderr, "kernel_launch: unexpected shapes: n_in %d out %d ws %zu (need %zu)\n", n_in, out_size, ws_size, (size_t)WS_END); grid = -1; return; }
        int dev = 0, cus = 0, per_cu = 0;
        hipGetDevice(&dev); hipDeviceGetAttribute(&cus, hipDeviceAttributeMultiprocessorCount, dev);
        if (hipFuncSetAttribute((const void*)hybrid_fwd, hipFuncAttributeMaxDynamicSharedMemorySize, LDS_BYTES) != hipSuccess) { fprintf(stderr, "kernel_launch: hipFuncSetAttribute failed\n"); grid = -1; return; }
        if (hipOccupancyMaxActiveBlocksPerMultiprocessor(&per_cu, (const void*)hybrid_fwd, 512, LDS_BYTES) != hipSuccess || per_cu < 1) { fprintf(stderr, "kernel_launch: occupancy query gave %d\n", per_cu); per_cu = 1; }
        (void)hipGetLastError();
        grid = cus * per_cu;
        fprintf(stderr, "kernel_launch: grid %d (%d CUs x %d)\n", grid, cus, per_cu);
    }
    if (grid < 0) return;
    Args a{};
    for (int i = 0; i < 22; ++i) a.in[i] = (const float*)d_in[i];
    a.out = (float*)d_out; a.ws = (unsigned char*)d_ws;
    if (hipMemsetAsync((char*)d_ws + WS_BAR, 0, XCD_BAR_WORDS * 4, stream) != hipSuccess) { fprintf(stderr, "kernel_launch: hipMemsetAsync failed\n"); return; }
    void* args[] = {&a};
    hipError_t e = hipLaunchCooperativeKernel((const void*)hybrid_fwd, dim3(grid), dim3(512), args, LDS_BYTES, stream);
    if (e != hipSuccess) fprintf(stderr, "kernel_launch: cooperative launch failed: %s (grid %d)\n", hipGetErrorString(e), grid);
}
```

```cpp
#include <hip/hip_runtime.h>
#include <hip/hip_cooperative_groups.h>
#include <cstdio>
#include <cstdint>
namespace cg = cooperative_groups;
__device__ __forceinline__ int tid_l() { int t = threadIdx.x; asm volatile("" : "+v"(t)); return t; }
namespace pg8 {
#define PG8_LAS __attribute__((address_space(3)))
typedef unsigned short bf16_t;
typedef short bf16x8 __attribute__((ext_vector_type(8)));
typedef float f32x4 __attribute__((ext_vector_type(4)));
typedef unsigned u32x4 __attribute__((ext_vector_type(4)));
constexpr int BM = 256, BK = 64, HALF = 128, HTB = HALF * BK * 2  , STAGE_BYTES = 8 * HTB, NXCD = 8, WGM = 8;

__host__ __device__ __forceinline__ int lds_byte(int r, int c) { const int st = (r >> 4) * 2 + (c >> 5), rr = r & 15, cc = c & 31, ob = rr * 64 + cc * 2; return st * 1024 + (ob ^ (((ob >> 9) & 1) << 5)); }
__host__ __device__ __forceinline__ void stage_rc(int b, int& R, int& C) { const int st = b / 1024, sb = b % 1024, swz = sb ^ (((sb >> 9) & 1) << 5); R = (st >> 1) * 16 + swz / 64; C = (st & 1) * 32 + (swz % 64) / 2; }
__host__ __device__ __forceinline__ int perm32(int rho) { const int n = rho >> 4, i = rho & 15; return 8 * (i >> 2) + 4 * n + (i & 3); }

struct Unit { int pm, pn; };
struct Gemm { const bf16_t* A; const bf16_t* Bt; int M, N, K; };

struct StaticOrder {
    int nM, nN, nwg, G, c;
    __host__ __device__ void init(int M, int N, int G_, int c_) { nM = M / BM; nN = N / BM; nwg = nM * nN; G = G_; c = c_; }
    __host__ __device__ bool next(int i, Unit& u) const {
        const long L = (long)i * G + c; if (L >= nwg) return false;
        int wgid = (int)L; { const int q = nwg / NXCD, r = nwg % NXCD, xcd = wgid % NXCD, off = wgid / NXCD; wgid = (xcd < r ? xcd * (q + 1) : r * (q + 1) + (xcd - r) * q) + off; }
        const int nig = WGM * nN, gid = wgid / nig, fm = gid * WGM, gsz = (nM - fm) < WGM ? (nM - fm) : WGM;
        u.pm = fm + ((wgid % nig) % gsz); u.pn = (wgid % nig) / gsz; return true;
    }
    __device__ __forceinline__ void a_ready(const Unit&) const {}
    __device__ __forceinline__ void done(const Unit&) const {}
};

typedef float f32x2_cv __attribute__((ext_vector_type(2))); typedef __bf16 bf16x2_cv __attribute__((ext_vector_type(2)));
__device__ __forceinline__ unsigned cvt_pk_bf16(float lo, float hi) { f32x2_cv v = {lo, hi}; bf16x2_cv b = __builtin_convertvector(v, bf16x2_cv); return __builtin_bit_cast(unsigned, b); }
template <class Epi, class Sched, bool ALIGN_EPI = false, bool SP2 = false>
__device__ __forceinline__ void gemm_phase(PG8_LAS unsigned char* lds, const Gemm g, const Sched& S, const Epi& E) {
    const int tid = tid_l(), wid = __builtin_amdgcn_readfirstlane(tid >> 6), lane = tid & 63, wr = wid >> 2, wc = wid & 3, fr = lane & 15, fq = lane >> 4;
    const int K = g.K, nt = K / BK;
    unsigned voffA[2], voffB[2];
#pragma unroll
    for (int i = 0; i < 2; ++i) { int R, C; stage_rc(tid * 16 + i * 8192, R, C); const int Rb = Epi::PERM ? ((R & ~31) + perm32(R & 31)) : R;
        voffA[i] = (unsigned)(R * K + C) * 2u; voffB[i] = (unsigned)(Rb * K + C) * 2u; }
    const size_t kstep = (size_t)(BK * 2);
    const size_t hstep = (size_t)HALF * K * 2;
    const size_t tstep = 2 * hstep;
    const unsigned ldsw = (unsigned)wid * 1024u;
    const int aoff = lds_byte(wr * 64 + fr, fq * 8), boff = lds_byte(wc * 32 + fr, fq * 8);
#define PG8_SA(b, h) (((b) * 2 + (h)) * HTB)
#define PG8_SB(b, h) ((4 + (b) * 2 + (h)) * HTB)
#define PG8_STAGE(bufoff, gbase, voff) do { _Pragma("unroll") for (int _i = 0; _i < 2; ++_i) \
        __builtin_amdgcn_global_load_lds((const unsigned*)((const char*)(gbase) + (voff)[_i]), (PG8_LAS unsigned*)(lds + (bufoff) + ldsw + _i * 8192), 16, 0, 0); } while (0)
#define PG8_LDA(dst, b, h) do { _Pragma("unroll") for (int m = 0; m < 4; ++m) _Pragma("unroll") for (int k = 0; k < 2; ++k) dst[m][k] = *(const PG8_LAS bf16x8*)(lds + PG8_SA(b, h) + aoff + m * 2048 + k * 1024); } while (0)
#define PG8_LDB(dst, b, h) do { _Pragma("unroll") for (int n = 0; n < 2; ++n) _Pragma("unroll") for (int k = 0; k < 2; ++k) dst[n][k] = *(const PG8_LAS bf16x8*)(lds + PG8_SB(b, h) + boff + n * 2048 + k * 1024); } while (0)
#define PG8_MMA(ai, bj, At, Bt) do { __builtin_amdgcn_s_setprio(1); _Pragma("unroll") for (int m = 0; m < 4; ++m) _Pragma("unroll") for (int n = 0; n < 2; ++n) _Pragma("unroll") for (int k = 0; k < 2; ++k) \
        acc[ai][bj][m][n] = __builtin_amdgcn_mfma_f32_16x16x32_bf16(Bt[n][k], At[m][k], acc[ai][bj][m][n], 0, 0, 0); __builtin_amdgcn_s_setprio(0); } while (0)
#define PG8_WAIT_V(n) asm volatile("s_waitcnt vmcnt(" #n ")" ::: "memory")
#define PG8_WAIT_L(n) asm volatile("s_waitcnt lgkmcnt(" #n ")" ::: "memory")
#define PG8_BAR __builtin_amdgcn_s_barrier()
#define PG8_SCHED __builtin_amdgcn_sched_barrier(0)
    Unit cur, nxt; int ui = 0;
    if (!S.next(0, cur)) return;
    f32x4 acc[2][2][4][2];
#pragma unroll
    for (int a = 0; a < 2; ++a)
#pragma unroll
        for (int b = 0; b < 2; ++b)
#pragma unroll
            for (int m = 0; m < 4; ++m)
#pragma unroll
                for (int n = 0; n < 2; ++n) acc[a][b][m][n] = (f32x4){0.f, 0.f, 0.f, 0.f};
    bf16x8 At[4][2], B0[2][2], B1[2][2];
    const char* cA = (const char*)g.A + (size_t)cur.pm * tstep; const char* cB = (const char*)g.Bt + (size_t)cur.pn * tstep;
    S.a_ready(cur);
    if constexpr (SP2) {
        PG8_STAGE(PG8_SB(0, 0), cB, voffB); PG8_STAGE(PG8_SB(0, 1), cB + hstep, voffB); PG8_STAGE(PG8_SA(0, 0), cA, voffA); PG8_STAGE(PG8_SA(0, 1), cA + hstep, voffA);
        if (wr == 1) PG8_BAR;
        PG8_WAIT_V(2); PG8_BAR;
        PG8_STAGE(PG8_SB(1, 0), cB + kstep, voffB); PG8_STAGE(PG8_SA(1, 0), cA + kstep, voffA); PG8_STAGE(PG8_SB(1, 1), cB + hstep + kstep, voffB);
        PG8_WAIT_V(6); PG8_BAR;
    } else {
        PG8_STAGE(PG8_SB(0, 0), cB, voffB); PG8_STAGE(PG8_SA(0, 0), cA, voffA); PG8_STAGE(PG8_SB(0, 1), cB + hstep, voffB); PG8_STAGE(PG8_SA(0, 1), cA + hstep, voffA);
        if (wr == 1) PG8_BAR;
        PG8_WAIT_V(4); PG8_BAR;
        PG8_STAGE(PG8_SB(1, 0), cB + kstep, voffB); PG8_STAGE(PG8_SA(1, 0), cA + kstep, voffA); PG8_STAGE(PG8_SB(1, 1), cB + hstep + kstep, voffB);
        PG8_WAIT_V(6); PG8_BAR;
    }
    for (;;) {
        const bool has_next = S.next(ui + 1, nxt);
        const char* nA = has_next ? (const char*)g.A + (size_t)nxt.pm * tstep : cA; const char* nB = has_next ? (const char*)g.Bt + (size_t)nxt.pn * tstep : cB;
        for (int t = 0; t < nt; t += 2) {
            const bool last = (t == nt - 2);
            const char* a1 = cA + (size_t)(t + 1) * kstep;
            const char* a2 = last ? nA : cA + (size_t)(t + 2) * kstep; const char* b2 = last ? nB : cB + (size_t)(t + 2) * kstep;
            const char* a3 = a2 + kstep; const char* b3 = b2 + kstep;
            if (last && has_next) S.a_ready(nxt);
            if constexpr (SP2) {
            PG8_LDB(B0, 0, 0); PG8_LDB(B1, 0, 1); PG8_SCHED; PG8_LDA(At, 0, 0); PG8_STAGE(PG8_SA(1, 1), a1 + hstep, voffA);
            PG8_WAIT_V(8); PG8_WAIT_L(0); PG8_BAR; PG8_MMA(0, 0, At, B0); PG8_MMA(0, 1, At, B1); PG8_BAR; PG8_SCHED;
            PG8_LDA(At, 0, 1); PG8_STAGE(PG8_SB(0, 0), b2, voffB); PG8_STAGE(PG8_SB(0, 1), b2 + hstep, voffB); PG8_STAGE(PG8_SA(0, 0), a2, voffA);
            PG8_WAIT_V(8); PG8_WAIT_L(0); PG8_BAR; PG8_MMA(1, 0, At, B0); PG8_MMA(1, 1, At, B1); PG8_BAR; PG8_SCHED;
            PG8_LDB(B0, 1, 0); PG8_LDB(B1, 1, 1); PG8_SCHED; PG8_LDA(At, 1, 0); PG8_STAGE(PG8_SA(0, 1), a2 + hstep, voffA);
            PG8_WAIT_V(8); PG8_WAIT_L(0); PG8_BAR; PG8_MMA(0, 0, At, B0); PG8_MMA(0, 1, At, B1); PG8_BAR; PG8_SCHED;
            PG8_LDA(At, 1, 1); PG8_STAGE(PG8_SB(1, 0), b3, voffB); PG8_STAGE(PG8_SB(1, 1), b3 + hstep, voffB); PG8_STAGE(PG8_SA(1, 0), a3, voffA);
            PG8_WAIT_V(8); PG8_WAIT_L(0); PG8_BAR; PG8_MMA(1, 0, At, B0); PG8_MMA(1, 1, At, B1); PG8_BAR; PG8_SCHED;
            } else {
            PG8_LDB(B0, 0, 0); PG8_SCHED; PG8_LDA(At, 0, 0); PG8_STAGE(PG8_SA(1, 1), a1 + hstep, voffA);
            PG8_WAIT_L(8); PG8_BAR; PG8_WAIT_L(0); PG8_MMA(0, 0, At, B0); PG8_BAR; PG8_SCHED;
            PG8_LDB(B1, 0, 1); PG8_STAGE(PG8_SB(0, 0), b2, voffB);
            PG8_BAR; PG8_WAIT_L(0); PG8_MMA(0, 1, At, B1); PG8_BAR;
            PG8_LDA(At, 0, 1); PG8_STAGE(PG8_SA(0, 0), a2, voffA);
            PG8_BAR; PG8_WAIT_L(0); PG8_MMA(1, 0, At, B0); PG8_BAR; PG8_SCHED;
            PG8_STAGE(PG8_SB(0, 1), b2 + hstep, voffB);
            PG8_WAIT_V(6); PG8_BAR; PG8_MMA(1, 1, At, B1); PG8_BAR;
            PG8_LDB(B0, 1, 0); PG8_SCHED; PG8_LDA(At, 1, 0); PG8_STAGE(PG8_SA(0, 1), a2 + hstep, voffA);
            PG8_WAIT_L(8); PG8_BAR; PG8_WAIT_L(0); PG8_MMA(0, 0, At, B0); PG8_BAR; PG8_SCHED;
            PG8_LDB(B1, 1, 1); PG8_STAGE(PG8_SB(1, 0), b3, voffB);
            PG8_BAR; PG8_WAIT_L(0); PG8_MMA(0, 1, At, B1); PG8_BAR;
            PG8_LDA(At, 1, 1); PG8_STAGE(PG8_SA(1, 0), a3, voffA);
            PG8_BAR; PG8_WAIT_L(0); PG8_MMA(1, 0, At, B0); PG8_BAR; PG8_SCHED;
            PG8_STAGE(PG8_SB(1, 1), b3 + hstep, voffB);
            PG8_WAIT_V(6); PG8_BAR; PG8_MMA(1, 1, At, B1); PG8_BAR;
            }
        }
        if constexpr (ALIGN_EPI) { if (wr == 0) PG8_BAR; }
        if constexpr (!Epi::AFTER_DRAIN) { E(acc, cur, wr, wc, fr, fq); S.done(cur); }
        if (!has_next) break;
#pragma unroll
        for (int a = 0; a < 2; ++a)
#pragma unroll
            for (int b = 0; b < 2; ++b)
#pragma unroll
                for (int m = 0; m < 4; ++m)
#pragma unroll
                    for (int n = 0; n < 2; ++n) acc[a][b][m][n] = (f32x4){0.f, 0.f, 0.f, 0.f};
        cur = nxt; cA = nA; cB = nB; ++ui;
        if constexpr (ALIGN_EPI) { if (wr == 1) PG8_BAR; }
    }
    PG8_WAIT_V(0);
    if constexpr (!ALIGN_EPI) { if (wr == 0) PG8_BAR; }
    PG8_BAR;
    if constexpr (Epi::AFTER_DRAIN) { E.fused(acc, cur, wr, wc, fr, fq, lds, wid, lane); S.done(cur); }
#undef PG8_SA
#undef PG8_SB
#undef PG8_STAGE
#undef PG8_LDA
#undef PG8_LDB
#undef PG8_MMA
#undef PG8_WAIT_V
#undef PG8_WAIT_L
#undef PG8_BAR
#undef PG8_SCHED
}
}
namespace pg8 {
typedef unsigned u32x2 __attribute__((ext_vector_type(2)));
constexpr float RMS_EPS = 1e-6f;
constexpr float LOG2E = 1.4426950408889634f;
__device__ __forceinline__ float silu_f(float x) { return x * __builtin_amdgcn_rcpf(1.0f + __builtin_amdgcn_exp2f(-x * LOG2E)); }
__device__ __forceinline__ float row_rstd(const float* rsp, int row, int fq) {
    const f32x4 v = *(const f32x4*)(rsp + (size_t)row * 16 + 4 * fq);
    float s = (v[0] + v[1]) + (v[2] + v[3]); s += __shfl_xor(s, 16); s += __shfl_xor(s, 32);
    return rsqrtf(s * (1.0f / 1024.0f) + RMS_EPS);
}
struct EpiSwiGLU {
    static constexpr bool PERM = true, AFTER_DRAIN = false;
    bf16_t* O; const float* rsp; int ldc;
    __device__ __forceinline__ void operator()(const f32x4 (&acc)[2][2][4][2], const Unit& u, int wr, int wc, int fr, int fq) const {
        const int row0 = u.pm * BM + wr * 64 + fr, col0 = u.pn * HALF + wc * 32 + 8 * fq;
#pragma unroll
        for (int ai = 0; ai < 2; ++ai)
#pragma unroll
            for (int m = 0; m < 4; ++m) {
                const int row = row0 + ai * HALF + m * 16; const float rs = row_rstd(rsp, row, fq);
                const float nrs = -LOG2E * rs, rs2 = rs * rs;
                const f32x4 g0 = acc[ai][0][m][0], g1 = acc[ai][0][m][1], u0 = acc[ai][1][m][0], u1 = acc[ai][1][m][1];
                const f32x4 a0 = g0 * nrs, a1 = g1 * nrs;
                f32x4 e0, e1;
#pragma unroll
                for (int q = 0; q < 4; ++q) { e0[q] = __builtin_amdgcn_exp2f(a0[q]); e1[q] = __builtin_amdgcn_exp2f(a1[q]); }
                const f32x4 d0 = e0 + 1.0f, d1 = e1 + 1.0f;
                f32x4 r0, r1;
#pragma unroll
                for (int q = 0; q < 4; ++q) { r0[q] = __builtin_amdgcn_rcpf(d0[q]); r1[q] = __builtin_amdgcn_rcpf(d1[q]); }
                const f32x4 o0 = ((g0 * u0) * rs2) * r0, o1 = ((g1 * u1) * rs2) * r1;
                u32x4 w; w.x = cvt_pk_bf16(o0[0], o0[1]); w.y = cvt_pk_bf16(o0[2], o0[3]); w.z = cvt_pk_bf16(o1[0], o1[1]); w.w = cvt_pk_bf16(o1[2], o1[3]);
                *(u32x4*)(O + (size_t)row * ldc + col0) = w;
            }
    }
};
struct EpiSplit {
    static constexpr bool PERM = true, AFTER_DRAIN = false;
    bf16_t* O; int ldc; int tiles_per_split; size_t split_stride; const float* rsp; float scale0; float* dt_out; int dt_tile;
    __device__ __forceinline__ void operator()(const f32x4 (&acc)[2][2][4][2], const Unit& u, int wr, int wc, int fr, int fq) const {
        const int row0 = u.pm * BM + wr * 64 + fr;
        if (u.pn == dt_tile) {
            if (wc == 0) {
#pragma unroll
                for (int ai = 0; ai < 2; ++ai)
#pragma unroll
                    for (int m = 0; m < 4; ++m) {
                        const int row = row0 + ai * HALF + m * 16; const float rs = row_rstd(rsp, row, fq);
#pragma unroll
                        for (int n = 0; n < 2; ++n) *(f32x4*)(dt_out + (size_t)row * 32 + 8 * fq + 4 * n) = acc[ai][0][m][n] * rs;
                    }
            } else {
#pragma unroll
                for (int ai = 0; ai < 2; ++ai)
#pragma unroll
                    for (int m = 0; m < 4; ++m) (void)row_rstd(rsp, row0 + ai * HALF + m * 16, fq);
            }
            return;
        }
        const int t = u.pn / tiles_per_split; bf16_t* base = O + (size_t)t * split_stride; const int colt = (u.pn - t * tiles_per_split) * BM + wc * 32 + 8 * fq;
        const float sc = (t == 0) ? scale0 : 1.0f;
#pragma unroll
        for (int ai = 0; ai < 2; ++ai)
#pragma unroll
            for (int m = 0; m < 4; ++m) {
                const int row = row0 + ai * HALF + m * 16; const float rs = row_rstd(rsp, row, fq) * sc;
                bf16_t* rowp = base + (size_t)row * ldc + colt;
#pragma unroll
                for (int bj = 0; bj < 2; ++bj) {
                    const f32x4 v0 = acc[ai][bj][m][0] * rs, v1 = acc[ai][bj][m][1] * rs;
                    u32x4 w; w.x = cvt_pk_bf16(v0[0], v0[1]); w.y = cvt_pk_bf16(v0[2], v0[3]); w.z = cvt_pk_bf16(v1[0], v1[1]); w.w = cvt_pk_bf16(v1[2], v1[3]);
                    *(u32x4*)(rowp + bj * HALF) = w;
                }
            }
    }
};
struct EpiResid {
    static constexpr bool PERM = true, AFTER_DRAIN = false;
    bf16_t* XB; float* rsp_out; float alpha;
    __device__ __forceinline__ void operator()(const f32x4 (&acc)[2][2][4][2], const Unit& u, int wr, int wc, int fr, int fq) const {
        const int row0 = u.pm * BM + wr * 64 + fr, col0 = u.pn * BM + wc * 32 + 8 * fq;
#pragma unroll
        for (int ai = 0; ai < 2; ++ai)
#pragma unroll
            for (int m = 0; m < 4; ++m) {
                const int row = row0 + ai * HALF + m * 16; float ss = 0.f;
#pragma unroll
                for (int bj = 0; bj < 2; ++bj) {
                    const size_t off = (size_t)row * 1024 + col0 + bj * HALF;
                    const u32x4 xv = *(const u32x4*)(XB + off);
                    f32x4 x0 = {__uint_as_float(xv.x << 16), __uint_as_float(xv.x & 0xffff0000u), __uint_as_float(xv.y << 16), __uint_as_float(xv.y & 0xffff0000u)};
                    f32x4 x1 = {__uint_as_float(xv.z << 16), __uint_as_float(xv.z & 0xffff0000u), __uint_as_float(xv.w << 16), __uint_as_float(xv.w & 0xffff0000u)};
                    x0 = x0 + acc[ai][bj][m][0] * alpha; x1 = x1 + acc[ai][bj][m][1] * alpha;
                    u32x4 w; w.x = cvt_pk_bf16(x0[0], x0[1]); w.y = cvt_pk_bf16(x0[2], x0[3]); w.z = cvt_pk_bf16(x1[0], x1[1]); w.w = cvt_pk_bf16(x1[2], x1[3]);
                    *(u32x4*)(XB + off) = w;
                    ss += (x0[0] * x0[0] + x0[1] * x0[1]) + (x0[2] * x0[2] + x0[3] * x0[3]) + (x1[0] * x1[0] + x1[1] * x1[1]) + (x1[2] * x1[2] + x1[3] * x1[3]);
                }
                ss += __shfl_xor(ss, 16); ss += __shfl_xor(ss, 32);
                if (fq == 0) rsp_out[(size_t)row * 16 + u.pn * 4 + wc] = ss;
            }
    }
};
}
#define LAS __attribute__((address_space(3)))
typedef unsigned short bf16;
typedef float f32x4 __attribute__((ext_vector_type(4)));
typedef float f32x16 __attribute__((ext_vector_type(16)));
typedef short bf16x8 __attribute__((ext_vector_type(8)));
typedef unsigned u32x4 __attribute__((ext_vector_type(4)));
typedef unsigned u32x2 __attribute__((ext_vector_type(2)));
constexpr int NB = 4, SEQ = 4096, T = NB * SEQ, DM = 1024, FF = 2816, DEPTH = 4;
constexpr int SSD_IN = 6176, SSD_IN_PAD = 6400, NCHUNK = 32;
constexpr float RMS_EPS = 1e-6f, LOG2E = 1.4426950408889634f;
constexpr float SB_C2 = 0.125f * LOG2E;
constexpr size_t MiB = 1u << 20;
constexpr size_t WS_RSP = 0;
constexpr size_t WS_DT = 1 * MiB;
constexpr size_t WS_ACUM = 3 * MiB;
constexpr size_t WS_ALAST = 5 * MiB;
constexpr size_t WS_BAR = 5 * MiB + 256 * 1024;
constexpr size_t WS_XB = 5 * MiB + 512 * 1024;
constexpr size_t WS_W = WS_XB + 32 * MiB;
constexpr size_t W_GU1 = WS_W, W_D1 = W_GU1 + 11 * MiB, W_GU2 = W_D1 + 5 * MiB + 512 * 1024, W_D2 = W_GU2 + 11 * MiB, W_IN = W_D2 + 5 * MiB + 512 * 1024, W_OUT = W_IN + 12 * MiB + 512 * 1024;
constexpr size_t WS_AR = W_OUT + 4 * MiB;
constexpr size_t WS_END = WS_AR + 320 * MiB;
static_assert(WS_AR == 87 * MiB, "ws map");
constexpr int LDS_BYTES = 147456;
#ifndef MAXSTEP
#define MAXSTEP (8 * DEPTH)
#endif

struct Args { const float* in[22]; float* out; unsigned char* ws; };
typedef const Args __attribute__((address_space(4)))* ArgsP;
__device__ __forceinline__ ArgsP get_args() { ArgsP p = (ArgsP)__builtin_amdgcn_kernarg_segment_ptr(); asm volatile("" : "+s"(p)); return p; }

__device__ __forceinline__ unsigned cvt_pk(float lo, float hi) { return pg8::cvt_pk_bf16(lo, hi); }
__device__ __forceinline__ float bf_lo(unsigned u) { return __uint_as_float(u << 16); }
__device__ __forceinline__ float bf_hi(unsigned u) { return __uint_as_float(u & 0xffff0000u); }
__device__ __forceinline__ float bf_us(unsigned short u) { return __uint_as_float(((unsigned)u) << 16); }
__device__ __forceinline__ float silu_f(float x) { return x * __builtin_amdgcn_rcpf(1.0f + __builtin_amdgcn_exp2f(-x * LOG2E)); }
__device__ __forceinline__ float wave_sum(float v) {
#pragma unroll
    for (int o = 1; o < 64; o <<= 1) v += __shfl_xor(v, o);
    return v;
}
#define LDS_WAIT() asm volatile("s_waitcnt lgkmcnt(0)" ::: "memory")

struct TrDesc { const float* W; bf16* WT; const float* gain; int K, N, mode, item; };
struct TrRegs { f32x4 v[8]; float g[8]; };
__device__ __forceinline__ void tr_load(const TrDesc& d, TrRegs& R, int lane) {
    const int nblk = d.N / 32, kb = d.item / nblk, nb = d.item % nblk, k0 = 64 * kb, n0 = 32 * nb;
    const float* p = d.W + (size_t)(k0 + 2 * (lane >> 3)) * d.N + n0 + 4 * (lane & 7);
#pragma unroll
    for (int i = 0; i < 4; ++i) { R.v[2 * i] = *(const f32x4*)(p + (size_t)(16 * i) * d.N); R.v[2 * i + 1] = *(const f32x4*)(p + (size_t)(16 * i + 1) * d.N);
        R.g[2 * i] = d.gain ? d.gain[k0 + 2 * (lane >> 3) + 16 * i] : 1.0f; R.g[2 * i + 1] = d.gain ? d.gain[k0 + 2 * (lane >> 3) + 16 * i + 1] : 1.0f; }
}
__device__ __forceinline__ void tr_finish(const TrDesc& d, const TrRegs& R, LAS float* scrf, int lane) {
    LAS unsigned* scr = (LAS unsigned*)scrf;
    const int nblk = d.N / 32, kb = d.item / nblk, nb = d.item % nblk, k0 = 64 * kb, n0 = 32 * nb;
#pragma unroll
    for (int i = 0; i < 4; ++i) { const f32x4 a = R.v[2 * i] * R.g[2 * i], b = R.v[2 * i + 1] * R.g[2 * i + 1]; LAS unsigned* q = scr + (4 * (lane & 7)) * 36 + (lane >> 3) + 8 * i;
        q[0] = cvt_pk(a[0], b[0]); q[36] = cvt_pk(a[1], b[1]); q[72] = cvt_pk(a[2], b[2]); q[108] = cvt_pk(a[3], b[3]); }
    LDS_WAIT(); asm volatile("" ::: "memory");
    const int c = lane & 7;
#pragma unroll
    for (int j = 0; j < 4; ++j) {
        const int n = (lane >> 3) + 8 * j; const u32x4 o = *(const LAS u32x4*)(scr + n * 36 + 4 * c);
        int nn = n0 + n, row = nn;
        if (d.mode == 1) { const int up = nn >= FF; if (up) nn -= FF; row = 256 * (nn >> 7) + 128 * up + (nn & 127); }
        *(u32x4*)(d.WT + (size_t)row * d.K + k0 + 8 * c) = o;
    }
    LDS_WAIT(); asm volatile("" ::: "memory");
}

__device__ __forceinline__ void convert_layer(ArgsP ap, int layer, LAS unsigned char* lds, int segmask, int worker, int nworkers) {
    const int tid_ = tid_l(); const int lane = tid_ & 63, wave = __builtin_amdgcn_readfirstlane(tid_ >> 6);
    LAS float* scr = (LAS float*)(lds + wave * 16384);
    const int kind = layer % 3, j = layer / 3;
    unsigned char* ws = ap->ws;
    const int n_in = (kind == 1) ? SSD_IN : 3 * DM, k_out = (kind == 1) ? 2 * DM : DM;
    const float* w_in = (kind == 0) ? ap->in[8] + (size_t)j * DM * 3 * DM : (kind == 1) ? ap->in[10] + (size_t)j * DM * SSD_IN : ap->in[18] + (size_t)j * DM * 3 * DM;
    const float* w_out = (kind == 0) ? ap->in[9] + (size_t)j * DM * DM : (kind == 1) ? ap->in[17] + (size_t)j * 2 * DM * DM : ap->in[20] + (size_t)j * DM * DM;
    const int I_GU1 = (segmask & 1) ? (DM / 64) * (2 * FF / 32) : 0, I_GU2 = (segmask & 2) ? (DM / 64) * (2 * FF / 32) : 0, I_D1 = (segmask & 4) ? (FF / 64) * (DM / 32) : 0, I_D2 = (segmask & 8) ? (FF / 64) * (DM / 32) : 0;
    const int I_IN = (segmask & 16) ? (DM / 64) * (n_in / 32) : 0, I_OUT = (segmask & 32) ? (k_out / 64) * (DM / 32) : 0;
    const int total = I_GU1 + I_GU2 + I_D1 + I_D2 + I_IN + I_OUT;
    const int gw = worker * 8 + wave, NGW = nworkers * 8;
#define TR_DECODE(D, IT) do { int r_ = (IT); \
        if (r_ < I_GU1) { D = TrDesc{ap->in[2] + (size_t)layer * DM * 2 * FF, (bf16*)(ws + W_GU1), ap->in[1] + layer * DM, DM, 2 * FF, 1, r_}; break; } r_ -= I_GU1; \
        if (r_ < I_GU2) { D = TrDesc{ap->in[6] + (size_t)layer * DM * 2 * FF, (bf16*)(ws + W_GU2), ap->in[5] + layer * DM, DM, 2 * FF, 1, r_}; break; } r_ -= I_GU2; \
        if (r_ < I_D1) { D = TrDesc{ap->in[3] + (size_t)layer * FF * DM, (bf16*)(ws + W_D1), nullptr, FF, DM, 0, r_}; break; } r_ -= I_D1; \
        if (r_ < I_D2) { D = TrDesc{ap->in[7] + (size_t)layer * FF * DM, (bf16*)(ws + W_D2), nullptr, FF, DM, 0, r_}; break; } r_ -= I_D2; \
        if (r_ < I_IN) { D = TrDesc{w_in, (bf16*)(ws + W_IN), ap->in[4] + layer * DM, DM, n_in, 0, r_}; break; } r_ -= I_IN; \
        D = TrDesc{w_out, (bf16*)(ws + W_OUT), nullptr, k_out, DM, 0, r_}; } while (0)
    if (gw < total) {
        TrDesc cur; TrRegs rc; TR_DECODE(cur, gw); tr_load(cur, rc, lane);
        for (int it = gw; it < total; it += NGW) {
            TrDesc nxt = cur; TrRegs rn = rc; const bool has = (it + NGW < total);
            if (has) { TR_DECODE(nxt, it + NGW); tr_load(nxt, rn, lane); }
            tr_finish(cur, rc, scr, lane);
            cur = nxt; rc = rn;
        }
    }
#undef TR_DECODE
}

__device__ __forceinline__ void init_rows(ArgsP ap) {
    const int tid_ = tid_l(); const int lane = tid_ & 63, wave = tid_ >> 6;
    const int gw = blockIdx.x * 8 + wave, NGW = gridDim.x * 8;
    bf16* xb = (bf16*)(ap->ws + WS_XB); float* rsp = (float*)(ap->ws + WS_RSP);
    for (int row = gw; row < T; row += NGW) {
        const f32x4* xr = (const f32x4*)(ap->in[0] + (size_t)row * DM) + lane; u32x2* xbr = (u32x2*)(xb + (size_t)row * DM) + lane; float s = 0.f;
#pragma unroll
        for (int jj = 0; jj < 4; ++jj) { const f32x4 v = xr[64 * jj]; u32x2 w; w.x = cvt_pk(v[0], v[1]); w.y = cvt_pk(v[2], v[3]); xbr[64 * jj] = w; s += (v[0] * v[0] + v[1] * v[1]) + (v[2] * v[2] + v[3] * v[3]); }
        s = wave_sum(s);
        if (lane < 4) { f32x4 o = {0.f, 0.f, 0.f, 0.f}; if (lane == 0) o[0] = s; *(f32x4*)(rsp + (size_t)row * 16 + 4 * lane) = o; }
    }
}
__device__ __forceinline__ void final_norm(ArgsP ap) {
    const int tid_ = tid_l(); const int lane = tid_ & 63, wave = tid_ >> 6;
    const int gw = blockIdx.x * 8 + wave, NGW = gridDim.x * 8;
    const float* rsp = (const float*)(ap->ws + WS_RSP); const float* g = ap->in[21]; const bf16* xb = (const bf16*)(ap->ws + WS_XB);
    for (int row = gw; row < T; row += NGW) {
        float s = (lane < 16) ? rsp[(size_t)row * 16 + lane] : 0.f; s = wave_sum(s);
        const float rs = rsqrtf(s * (1.0f / DM) + RMS_EPS);
        f32x4* orow = (f32x4*)(ap->out + (size_t)row * DM) + lane; const f32x4* gr = (const f32x4*)g + lane; const u32x2* xr = (const u32x2*)(xb + (size_t)row * DM) + lane;
#pragma unroll
        for (int jj = 0; jj < 4; ++jj) { const u32x2 xv = xr[64 * jj]; const f32x4 gg = gr[64 * jj]; f32x4 v = {bf_lo(xv.x), bf_hi(xv.x), bf_lo(xv.y), bf_hi(xv.y)}; v = v * rs * gg; orow[64 * jj] = v; }
    }
}

__device__ __forceinline__ void shortconv_phase(const bf16* bg, const bf16* cgp, const bf16* hg, const float* cw, bf16* out) {
    const int nthr = gridDim.x * 512;
    for (int idx = blockIdx.x * 512 + tid_l(); idx < (T / 4) * 128; idx += nthr) {
        const int c8 = idx & 127, row0 = (idx >> 7) * 4, tpos0 = row0 & (SEQ - 1);
        f32x4 w0[3], w1[3];
#pragma unroll
        for (int k = 0; k < 3; ++k) { w0[k] = *(const f32x4*)(cw + k * DM + 8 * c8); w1[k] = *(const f32x4*)(cw + k * DM + 8 * c8 + 4); }
        f32x4 pa[6], pb[6];
        u32x4 bv[4];
#pragma unroll
        for (int t = 0; t < 6; ++t) {
            pa[t] = (f32x4){0.f, 0.f, 0.f, 0.f}; pb[t] = pa[t];
            if (tpos0 - 2 + t >= 0) {
                const size_t off = (size_t)(row0 - 2 + t) * DM + 8 * c8;
                const u32x4 cv = *(const u32x4*)(cgp + off), hv = *(const u32x4*)(hg + off);
                pa[t] = (f32x4){bf_lo(cv[0]) * bf_lo(hv[0]), bf_hi(cv[0]) * bf_hi(hv[0]), bf_lo(cv[1]) * bf_lo(hv[1]), bf_hi(cv[1]) * bf_hi(hv[1])};
                pb[t] = (f32x4){bf_lo(cv[2]) * bf_lo(hv[2]), bf_hi(cv[2]) * bf_hi(hv[2]), bf_lo(cv[3]) * bf_lo(hv[3]), bf_hi(cv[3]) * bf_hi(hv[3])};
            }
        }
#pragma unroll
        for (int t = 0; t < 4; ++t) bv[t] = *(const u32x4*)(bg + (size_t)(row0 + t) * DM + 8 * c8);
#pragma unroll
        for (int t = 0; t < 4; ++t) {
            const f32x4 ua = w0[0] * pa[t] + w0[1] * pa[t + 1] + w0[2] * pa[t + 2], ub = w1[0] * pb[t] + w1[1] * pb[t + 1] + w1[2] * pb[t + 2];
            u32x4 o; o[0] = cvt_pk(bf_lo(bv[t][0]) * ua[0], bf_hi(bv[t][0]) * ua[1]); o[1] = cvt_pk(bf_lo(bv[t][1]) * ua[2], bf_hi(bv[t][1]) * ua[3]);
            o[2] = cvt_pk(bf_lo(bv[t][2]) * ub[0], bf_hi(bv[t][2]) * ub[1]); o[3] = cvt_pk(bf_lo(bv[t][3]) * ub[2], bf_hi(bv[t][3]) * ub[3]);
            *(u32x4*)(out + (size_t)(row0 + t) * DM + 8 * c8) = o;
        }
    }
}
namespace sba {
constexpr int KS_OFF = 0, VT_OFF = 8192, VT_PITCH = 192, BUF_BYTES = VT_OFF + 64 * VT_PITCH, FLAG_OFF = 4 * BUF_BYTES;
typedef short v4i16_tr __attribute__((ext_vector_type(4)));
__device__ __forceinline__ void unit(LAS unsigned char* lds_all, const bf16* Q, const bf16* K, const bf16* V, bf16* O, int b, int hp, int qb) {
    const int tid = tid_l(), lane = tid & 63, r32 = lane & 31, hi = lane >> 5; const int wid = __builtin_amdgcn_readfirstlane(tid >> 6);
    const int hf = wid >> 2, h = 2 * hp + hf; LAS unsigned char* lds = lds_all + hf * (2 * BUF_BYTES);
    const size_t rowbase = (size_t)b * SEQ; const int q0 = qb * 128, qw0 = q0 + (wid & 3) * 32;
    bf16x8 qr[4];
    { const bf16* qp = Q + (rowbase + qw0 + r32) * DM + h * 64 + hi * 8;
#pragma unroll
      for (int d0 = 0; d0 < 4; ++d0) qr[d0] = *(const bf16x8*)(qp + d0 * 16); }
    f32x16 o0, o1;
#pragma unroll
    for (int r = 0; r < 16; ++r) { o0[r] = 0.f; o1[r] = 0.f; }
    float carry = 1.0f; bool done = false;
    const int NT = (q0 + 128) / 64;
    const int skey = (tid & 255) >> 2, sc = 2 * (tid & 3);
    const bf16* kg = K + (rowbase + skey) * DM + h * 64 + sc * 8; const bf16* vg = V + (rowbase + skey) * DM + h * 64 + sc * 8;
#define SBA_LOAD(TT) do { const size_t o_ = (size_t)(TT) * 64 * DM; kreg = *(const u32x4*)(kg + o_); kreg2 = *(const u32x4*)(kg + o_ + 8); vreg = *(const u32x4*)(vg + o_); vreg2 = *(const u32x4*)(vg + o_ + 8); } while (0)
    u32x4 kreg, kreg2, vreg, vreg2; SBA_LOAD(NT - 1);
#define SBA_STAGE(BUF) do { LAS unsigned char* bb_ = lds + (BUF) * BUF_BYTES; *(LAS u32x4*)(bb_ + KS_OFF + sc * 1024 + skey * 16) = kreg; *(LAS u32x4*)(bb_ + KS_OFF + (sc + 1) * 1024 + skey * 16) = kreg2; \
        *(LAS u32x4*)(bb_ + VT_OFF + skey * VT_PITCH + sc * 16) = vreg; *(LAS u32x4*)(bb_ + VT_OFF + skey * VT_PITCH + (sc + 1) * 16) = vreg2; } while (0)
    __syncthreads();
    SBA_STAGE(0);
    if (NT > 1) SBA_LOAD(NT - 2);
    __syncthreads();
    for (int t = NT - 1; t >= 0; --t) {
        const int cur = (NT - 1 - t) & 1;
        if (t > 0) SBA_STAGE(cur ^ 1);
        if (t > 1) SBA_LOAD(t - 2);
        if (!done && 64 * t <= qw0) {
            const LAS unsigned char* bb = lds + cur * BUF_BYTES;
            f32x16 p0, p1;
#pragma unroll
            for (int r = 0; r < 16; ++r) { p0[r] = 0.f; p1[r] = 0.f; }
            const LAS unsigned char* kb = bb + KS_OFF + hi * 1024 + r32 * 16;
#pragma unroll
            for (int d0 = 0; d0 < 4; ++d0) {
                const bf16x8 a0 = *(const LAS bf16x8*)(kb + d0 * 2048), a1 = *(const LAS bf16x8*)(kb + d0 * 2048 + 512);
                p0 = __builtin_amdgcn_mfma_f32_32x32x16_bf16(a0, qr[d0], p0, 0, 0, 0);
                p1 = __builtin_amdgcn_mfma_f32_32x32x16_bf16(a1, qr[d0], p1, 0, 0, 0);
            }
            const bool need_mask = (64 * t + 64 > qw0);
            const int qrel = qw0 + r32 - 64 * t;
            unsigned pw[16];
#pragma unroll
            for (int i = 7; i >= 0; --i) {
                const int half = i >> 2, rg = i & 3;
                f32x4 zv;
#pragma unroll
                for (int e = 0; e < 4; ++e) zv[e] = half ? p1[4 * rg + e] : p0[4 * rg + e];
                f32x4 ev;
#pragma unroll
                for (int e = 0; e < 4; ++e) ev[e] = __builtin_amdgcn_exp2f(-zv[e]);
                ev = ev + 1.0f;
                f32x4 bt;
#pragma unroll
                for (int e = 0; e < 4; ++e) bt[e] = __builtin_amdgcn_rcpf(ev[e]);
                if (need_mask) {
#pragma unroll
                    for (int e = 0; e < 4; ++e) { const int keyrel = 32 * half + 8 * rg + 4 * hi + e; if (keyrel >= qrel) bt[e] = 0.f; }
                }
                const f32x4 kp = 1.0f - bt;
                const float t3 = kp[3], t2 = t3 * kp[2], t1 = t2 * kp[1], tot = t1 * kp[0];
                const auto rr = __builtin_amdgcn_permlane32_swap(__float_as_uint(tot), __float_as_uint(tot), false, false);
                const float ta = __uint_as_float(rr[0]), tb = __uint_as_float(rr[1]);
                const float E = hi ? carry : carry * tb;
                carry = carry * (ta * tb);
                const f32x4 tv = {t1, t2, t3, 1.0f};
                const f32x4 pv = (bt * tv) * E;
                pw[2 * i] = cvt_pk(pv[0], pv[1]); pw[2 * i + 1] = cvt_pk(pv[2], pv[3]);
            }
            const LAS unsigned char* vb = bb + VT_OFF + (4 * hi + ((lane & 15) >> 2)) * VT_PITCH + (16 * ((lane >> 4) & 1) + 4 * (lane & 3)) * 2;
#pragma unroll
            for (int ks = 0; ks < 4; ++ks) {
                u32x4 bw; bw.x = pw[4 * ks]; bw.y = pw[4 * ks + 1]; bw.z = pw[4 * ks + 2]; bw.w = pw[4 * ks + 3];
                const bf16x8 bfrag = __builtin_bit_cast(bf16x8, bw);
#pragma unroll
                for (int dh = 0; dh < 2; ++dh) {
                    const v4i16_tr lo = __builtin_amdgcn_ds_read_tr16_b64_v4i16((LAS v4i16_tr*)(vb + (16 * ks) * VT_PITCH + dh * 64));
                    const v4i16_tr h2 = __builtin_amdgcn_ds_read_tr16_b64_v4i16((LAS v4i16_tr*)(vb + (16 * ks + 8) * VT_PITCH + dh * 64));
                    const bf16x8 afrag = (bf16x8){lo[0], lo[1], lo[2], lo[3], h2[0], h2[1], h2[2], h2[3]};
                    if (dh == 0) o0 = __builtin_amdgcn_mfma_f32_32x32x16_bf16(afrag, bfrag, o0, 0, 0, 0);
                    else o1 = __builtin_amdgcn_mfma_f32_32x32x16_bf16(afrag, bfrag, o1, 0, 0, 0);
                }
            }
            done = __all(carry == 0.0f);
        }
        if (lane == 0) *(LAS int*)(lds_all + FLAG_OFF + (cur * 8 + wid) * 4) = done ? 1 : 0;
        __syncthreads();
        { const u32x4 f0 = *(LAS u32x4*)(lds_all + FLAG_OFF + cur * 32), f1 = *(LAS u32x4*)(lds_all + FLAG_OFF + cur * 32 + 16);
          const unsigned alld = f0[0] & f0[1] & f0[2] & f0[3] & f1[0] & f1[1] & f1[2] & f1[3];
          if (__builtin_amdgcn_readfirstlane(alld) != 0u) break; }
    }
#undef SBA_STAGE
#undef SBA_LOAD
    bf16* op = O + (rowbase + qw0 + r32) * DM + h * 64 + 4 * hi;
#pragma unroll
    for (int rg = 0; rg < 4; ++rg) {
        u32x2 w0; w0.x = cvt_pk(o0[4 * rg], o0[4 * rg + 1]); w0.y = cvt_pk(o0[4 * rg + 2], o0[4 * rg + 3]); *(u32x2*)(op + 8 * rg) = w0;
        u32x2 w1; w1.x = cvt_pk(o1[4 * rg], o1[4 * rg + 1]); w1.y = cvt_pk(o1[4 * rg + 2], o1[4 * rg + 3]); *(u32x2*)(op + 32 + 8 * rg) = w1;
    }
}
__device__ __forceinline__ void phase(LAS unsigned char* lds, const bf16* Q, const bf16* K, const bf16* V, bf16* O) {
    for (int i = blockIdx.x; i < 1024; i += gridDim.x) {
        const int v = i & 255, rnd = i >> 8, bp = v >> 3, s = v & 7;
        const int qb = (rnd == 0) ? s : (rnd == 1) ? 15 - s : (rnd == 2) ? 16 + s : 31 - s;
        unit(lds, Q, K, V, O, bp >> 3, bp & 7, qb);
    }
}
}
namespace ssd {
constexpr int XN_OFF = 0, XN_PITCH = 528, BN_OFF = 128 * XN_PITCH, BN_PITCH = 272, CN_OFF = BN_OFF + 128 * BN_PITCH, DTV_OFF = CN_OFF + 128 * BN_PITCH, ACU_OFF = DTV_OFF + 2048, WTOT_OFF = ACU_OFF + 2048, S1_LDS = WTOT_OFF + 64;
static_assert(S1_LDS <= LDS_BYTES, "S1 LDS");
struct Bufs { const bf16* z; const bf16* xs_raw; const bf16* bc_raw; bf16* ypart; bf16* states; bf16* hprev; bf16* yn; bf16* cc; const float* dt_raw; float* acum; float* alast;
              const float* conv_w; const float* conv_b; const float* dt_bias; const float* a_log; const float* dsk; const float* ng; };

__device__ __forceinline__ u32x4 conv8(const bf16* src, size_t row, int tpos, int col, const float* cw, const float* cb, int cch) {
    float acc[8];
    { const f32x4 b0 = *(const f32x4*)(cb + cch), b1 = *(const f32x4*)(cb + cch + 4);
#pragma unroll
      for (int e = 0; e < 4; ++e) { acc[e] = b0[e]; acc[4 + e] = b1[e]; } }
#pragma unroll
    for (int k = 0; k < 4; ++k) {
        if (tpos - 3 + k >= 0) {
            const u32x4 raw = *(const u32x4*)(src + (row - 3 + k) * 2048 + col);
            const f32x4 w0 = *(const f32x4*)(cw + k * 4096 + cch), w1 = *(const f32x4*)(cw + k * 4096 + cch + 4);
            acc[0] += w0[0] * bf_lo(raw[0]); acc[1] += w0[1] * bf_hi(raw[0]); acc[2] += w0[2] * bf_lo(raw[1]); acc[3] += w0[3] * bf_hi(raw[1]);
            acc[4] += w1[0] * bf_lo(raw[2]); acc[5] += w1[1] * bf_hi(raw[2]); acc[6] += w1[2] * bf_lo(raw[3]); acc[7] += w1[3] * bf_hi(raw[3]);
        }
    }
    u32x4 o;
#pragma unroll
    for (int q = 0; q < 4; ++q) o[q] = cvt_pk(silu_f(acc[2 * q]), silu_f(acc[2 * q + 1]));
    return o;
}
typedef short v4i16_tr __attribute__((ext_vector_type(4)));
__device__ __forceinline__ bf16x8 tr8(const LAS unsigned char* p, int step_bytes) {
    const v4i16_tr lo = __builtin_amdgcn_ds_read_tr16_b64_v4i16((LAS v4i16_tr*)p), h2 = __builtin_amdgcn_ds_read_tr16_b64_v4i16((LAS v4i16_tr*)(p + step_bytes));
    return (bf16x8){lo[0], lo[1], lo[2], lo[3], h2[0], h2[1], h2[2], h2[3]};
}
__device__ __forceinline__ bf16x8 gather8(const LAS unsigned char* p, int pitch) {
    u32x4 w;
#pragma unroll
    for (int q = 0; q < 4; ++q) { const unsigned lo = *(const LAS unsigned short*)(p + (2 * q) * pitch), hh = *(const LAS unsigned short*)(p + (2 * q + 1) * pitch); w[q] = lo | (hh << 16); }
    return __builtin_bit_cast(bf16x8, w);
}

template <int NT> __device__ __forceinline__ void conv_load(u32x4 (&raw)[NT + 3], const bf16* src, size_t row0, int tpos0, int l0, int col) {
#pragma unroll
    for (int t = 0; t < NT + 3; ++t) { const int l = l0 - 3 + t; raw[t] = (u32x4){0u, 0u, 0u, 0u}; if (tpos0 + l >= 0) raw[t] = *(const u32x4*)(src + (row0 + l) * 2048 + col); }
}
template <int NT, class F> __device__ __forceinline__ void conv_compute(const u32x4 (&raw)[NT + 3], const float* cw, const float* cb, int cch, F out) {
    float w[4][8], bias[8];
#pragma unroll
    for (int k = 0; k < 4; ++k) { const f32x4 w0 = *(const f32x4*)(cw + k * 4096 + cch), w1 = *(const f32x4*)(cw + k * 4096 + cch + 4);
#pragma unroll
        for (int e = 0; e < 4; ++e) { w[k][e] = w0[e]; w[k][4 + e] = w1[e]; } }
    { const f32x4 b0 = *(const f32x4*)(cb + cch), b1 = *(const f32x4*)(cb + cch + 4);
#pragma unroll
      for (int e = 0; e < 4; ++e) { bias[e] = b0[e]; bias[4 + e] = b1[e]; } }
#pragma unroll
    for (int t = 0; t < NT; ++t) {
        float acc[8];
#pragma unroll
        for (int e = 0; e < 8; ++e) acc[e] = bias[e];
#pragma unroll
        for (int k = 0; k < 4; ++k) {
#pragma unroll
            for (int q = 0; q < 4; ++q) { acc[2 * q] += w[k][2 * q] * bf_lo(raw[t + k][q]); acc[2 * q + 1] += w[k][2 * q + 1] * bf_hi(raw[t + k][q]); }
        }
        u32x4 o;
#pragma unroll
        for (int q = 0; q < 4; ++q) o[q] = cvt_pk(silu_f(acc[2 * q]), silu_f(acc[2 * q + 1]));
        out(t, o);
    }
}

__device__ __forceinline__ void s1_item(LAS unsigned char* lds, const Bufs& B, int item) {
    const int tid = tid_l(), lane = tid & 63, r32 = lane & 31, hi = lane >> 5; const int wid = __builtin_amdgcn_readfirstlane(tid >> 6);
    const int g = item & 7, c = (item >> 3) & 31, b = item >> 8;
    const size_t row0 = (size_t)b * SEQ + c * 128; const int tpos0 = c * 128;
    const float dt_in = B.dt_raw[(row0 + (tid & 127)) * 32 + 4 * g + (tid >> 7)] + B.dt_bias[4 * g + (tid >> 7)], alog_in = B.a_log[4 * g + (tid >> 7)];
    __syncthreads();
    { const int c8x = tid & 31, l0x = 8 * (tid >> 5), c8 = tid & 15, l0 = 4 * (tid >> 4);
      u32x4 rx[11], rb[7], rc[7];
      conv_load<8>(rx, B.xs_raw, row0, tpos0, l0x, 256 * g + 8 * c8x);
      conv_load<4>(rb, B.bc_raw, row0, tpos0, l0, 128 * g + 8 * c8);
      conv_load<4>(rc, B.bc_raw, row0, tpos0, l0, 1024 + 128 * g + 8 * c8);
      conv_compute<8>(rx, B.conv_w, B.conv_b, 256 * g + 8 * c8x, [&](int t, u32x4 v) { *(LAS u32x4*)(lds + XN_OFF + (l0x + t) * XN_PITCH + c8x * 16) = v; });
      conv_compute<4>(rb, B.conv_w, B.conv_b, 2048 + 128 * g + 8 * c8, [&](int t, u32x4 v) { *(LAS u32x4*)(lds + BN_OFF + (l0 + t) * BN_PITCH + c8 * 16) = v; });
      conv_compute<4>(rc, B.conv_w, B.conv_b, 3072 + 128 * g + 8 * c8, [&](int t, u32x4 v) { *(LAS u32x4*)(lds + CN_OFF + (l0 + t) * BN_PITCH + c8 * 16) = v;
          *(u32x4*)(B.cc + (row0 + l0 + t) * 1024 + 128 * g + 8 * c8) = v; }); }
    float dtv, scan;
    { const int r = tid >> 7, l = tid & 127, hh = 4 * g + r;
      const float x = dt_in;
      dtv = (x > 20.f) ? x : log1pf(__expf(x));
      const float av = -__expf(alog_in);
      scan = dtv * av;
#pragma unroll
      for (int o = 1; o < 64; o <<= 1) { const float v = __shfl_up(scan, o); if (lane >= o) scan += v; }
      if (lane == 63) *(LAS float*)(lds + WTOT_OFF + wid * 4) = scan; }
    __syncthreads();
    { const int r = tid >> 7, l = tid & 127, hh = 4 * g + r;
      if (l >= 64) scan += *(LAS float*)(lds + WTOT_OFF + (wid - 1) * 4);
      *(LAS float*)(lds + ACU_OFF + (r * 128 + l) * 4) = scan; *(LAS float*)(lds + DTV_OFF + (r * 128 + l) * 4) = dtv;
      B.acum[(row0 + l) * 32 + hh] = scan;
      if (l == 127) B.alast[(b * NCHUNK + c) * 32 + hh] = scan; }
    __syncthreads();
    {
        const int r = wid >> 1, pb = wid & 1, head = 4 * g + r;
        const float al = *(const LAS float*)(lds + ACU_OFF + (r * 128 + 127) * 4);
        bf16x8 xa[8];
#pragma unroll
        for (int ks = 0; ks < 8; ++ks) {
            const int s0 = 16 * ks + 8 * hi;
            const f32x4 a0 = *(const LAS f32x4*)(lds + ACU_OFF + (r * 128 + s0) * 4), a1 = *(const LAS f32x4*)(lds + ACU_OFF + (r * 128 + s0 + 4) * 4);
            const f32x4 d0 = *(const LAS f32x4*)(lds + DTV_OFF + (r * 128 + s0) * 4), d1 = *(const LAS f32x4*)(lds + DTV_OFF + (r * 128 + s0 + 4) * 4);
            const bf16x8 xr8 = tr8(lds + XN_OFF + (s0 + ((lane & 15) >> 2)) * XN_PITCH + (64 * r + 32 * pb + 16 * ((lane >> 4) & 1) + 4 * (lane & 3)) * 2, 4 * XN_PITCH);
            float v[8];
#pragma unroll
            for (int j = 0; j < 8; ++j) { const float te = __expf(al - (j < 4 ? a0[j & 3] : a1[j & 3])) * (j < 4 ? d0[j & 3] : d1[j & 3]); v[j] = bf_us((unsigned short)xr8[j]) * te; }
            u32x4 w; w.x = cvt_pk(v[0], v[1]); w.y = cvt_pk(v[2], v[3]); w.z = cvt_pk(v[4], v[5]); w.w = cvt_pk(v[6], v[7]);
            xa[ks] = __builtin_bit_cast(bf16x8, w);
        }
        bf16* sp = B.states + ((((size_t)b * NCHUNK + c) * 32 + head) * 64 + 32 * pb + r32) * 128 + 4 * hi;
#pragma unroll 1
        for (int nb = 0; nb < 4; ++nb) {
            f32x16 st;
#pragma unroll
            for (int q = 0; q < 16; ++q) st[q] = 0.f;
#pragma unroll
            for (int ks = 0; ks < 8; ++ks) {
                const bf16x8 af = tr8(lds + BN_OFF + (16 * ks + 8 * hi + ((lane & 15) >> 2)) * BN_PITCH + (32 * nb + 16 * ((lane >> 4) & 1) + 4 * (lane & 3)) * 2, 4 * BN_PITCH);
                st = __builtin_amdgcn_mfma_f32_32x32x16_bf16(af, xa[ks], st, 0, 0, 0);
            }
#pragma unroll
            for (int rg = 0; rg < 4; ++rg) { u32x2 w; w.x = cvt_pk(st[4 * rg], st[4 * rg + 1]); w.y = cvt_pk(st[4 * rg + 2], st[4 * rg + 3]); *(u32x2*)(sp + 32 * nb + 8 * rg) = w; }
        }
    }
    const int lb = wid & 3, hp = wid >> 2, l = 32 * lb + r32;
    f32x16 yv[2][2];
    {
        bf16x8 cf[8];
#pragma unroll
        for (int k = 0; k < 8; ++k) cf[k] = *(const LAS bf16x8*)(lds + CN_OFF + l * BN_PITCH + (16 * k + 8 * hi) * 2);
        f32x16 cb[4];
#pragma unroll
        for (int sb = 0; sb < 4; ++sb) {
#pragma unroll
            for (int r = 0; r < 16; ++r) cb[sb][r] = 0.f;
            if (sb <= lb) {
#pragma unroll
                for (int k = 0; k < 8; ++k) { const bf16x8 af = *(const LAS bf16x8*)(lds + BN_OFF + (32 * sb + r32) * BN_PITCH + (16 * k + 8 * hi) * 2);
                    cb[sb] = __builtin_amdgcn_mfma_f32_32x32x16_bf16(af, cf[k], cb[sb], 0, 0, 0); }
            }
        }
#pragma unroll
        for (int hh = 0; hh < 2; ++hh) {
            const int r = 2 * hp + hh, head = 4 * g + r;
            const float acl = *(const LAS float*)(lds + ACU_OFF + (r * 128 + l) * 4);
            const float dsk = B.dsk[head];
            f32x16 y0, y1;
#pragma unroll
            for (int q = 0; q < 16; ++q) { y0[q] = 0.f; y1[q] = 0.f; }
#pragma unroll
            for (int sb = 0; sb < 4; ++sb) {
                if (sb <= lb) {
                    unsigned pwv[8];
#pragma unroll
                    for (int rg = 0; rg < 4; ++rg) {
                        const int sl = 32 * sb + 8 * rg + 4 * hi;
                        const f32x4 as4 = *(const LAS f32x4*)(lds + ACU_OFF + (r * 128 + sl) * 4), dt4 = *(const LAS f32x4*)(lds + DTV_OFF + (r * 128 + sl) * 4);
                        float w[4];
#pragma unroll
                        for (int e = 0; e < 4; ++e) { float v = cb[sb][4 * rg + e] * __expf(acl - as4[e]) * dt4[e]; if (sl + e > l) v = 0.f; if (sl + e == l) v += dsk; w[e] = v; }
                        pwv[2 * rg] = cvt_pk(w[0], w[1]); pwv[2 * rg + 1] = cvt_pk(w[2], w[3]);
                    }
#pragma unroll
                    for (int ks = 0; ks < 2; ++ks) {
                        u32x4 bw; bw.x = pwv[4 * ks]; bw.y = pwv[4 * ks + 1]; bw.z = pwv[4 * ks + 2]; bw.w = pwv[4 * ks + 3];
                        const bf16x8 bfrag = __builtin_bit_cast(bf16x8, bw);
                        const LAS unsigned char* xq = lds + XN_OFF + (32 * sb + 16 * ks + 4 * hi + ((lane & 15) >> 2)) * XN_PITCH + (64 * r + 16 * ((lane >> 4) & 1) + 4 * (lane & 3)) * 2;
#pragma unroll
                        for (int pb = 0; pb < 2; ++pb) {
                            const bf16x8 afrag = tr8(xq + pb * 64, 8 * XN_PITCH);
                            if (pb == 0) y0 = __builtin_amdgcn_mfma_f32_32x32x16_bf16(afrag, bfrag, y0, 0, 0, 0);
                            else y1 = __builtin_amdgcn_mfma_f32_32x32x16_bf16(afrag, bfrag, y1, 0, 0, 0);
                        }
                    }
                }
            }
            yv[hh][0] = y0; yv[hh][1] = y1;
        }
    }
    __syncthreads();
#pragma unroll
    for (int hh = 0; hh < 2; ++hh)
#pragma unroll
        for (int pb = 0; pb < 2; ++pb) {
            LAS unsigned char* yl = lds + XN_OFF + l * XN_PITCH + (64 * (2 * hp + hh) + 32 * pb + 4 * hi) * 2;
#pragma unroll
            for (int rg = 0; rg < 4; ++rg) { u32x2 w; w.x = cvt_pk(yv[hh][pb][4 * rg], yv[hh][pb][4 * rg + 1]); w.y = cvt_pk(yv[hh][pb][4 * rg + 2], yv[hh][pb][4 * rg + 3]); *(LAS u32x2*)(yl + 16 * rg) = w; }
        }
    __syncthreads();
#pragma unroll 4
    for (int i = 0; i < 8; ++i) { const int idx = tid + 512 * i, ll = idx >> 5, c8 = idx & 31;
        *(u32x4*)(B.ypart + (row0 + ll) * 2048 + 256 * g + 8 * c8) = *(const LAS u32x4*)(lds + XN_OFF + ll * XN_PITCH + c8 * 16); }
}

__device__ __forceinline__ void s2_phase(const Bufs& B) {
    const int nthr = gridDim.x * 512;
    for (int idx = blockIdx.x * 512 + tid_l(); idx < NB * 32 * 64 * 16; idx += nthr) {
        const int n8 = idx & 15, p = (idx >> 4) & 63, head = (idx >> 10) & 31, b = idx >> 15;
        float hacc[8];
#pragma unroll
        for (int e = 0; e < 8; ++e) hacc[e] = 0.f;
        const size_t base = (((size_t)b * NCHUNK) * 32 + head) * 8192 + p * 128 + 8 * n8;
        u32x4 nxt = *(const u32x4*)(B.states + base);
#pragma unroll 4
        for (int c = 0; c < NCHUNK; ++c) {
            const size_t off = base + (size_t)c * 32 * 8192;
            const u32x4 st = nxt;
            if (c + 1 < NCHUNK) nxt = *(const u32x4*)(B.states + off + (size_t)32 * 8192);
            u32x4 o;
#pragma unroll
            for (int q = 0; q < 4; ++q) o[q] = cvt_pk(hacc[2 * q], hacc[2 * q + 1]);
            *(u32x4*)(B.hprev + off) = o;
            const float dec = __expf(B.alast[(b * NCHUNK + c) * 32 + head]);
#pragma unroll
            for (int q = 0; q < 4; ++q) { hacc[2 * q] = hacc[2 * q] * dec + bf_lo(st[q]); hacc[2 * q + 1] = hacc[2 * q + 1] * dec + bf_hi(st[q]); }
        }
    }
}

constexpr int S3_Y = 0, S3_Z = 128 * XN_PITCH, S3_TAB = 2 * 128 * XN_PITCH;
__device__ __forceinline__ void s3_item(LAS unsigned char* lds, const Bufs& B, int item) {
    const int tid = tid_l(), lane = tid & 63, r32 = lane & 31, hi = lane >> 5; const int wid = __builtin_amdgcn_readfirstlane(tid >> 6);
    const int g = item & 7, c = (item >> 3) & 31, b = item >> 8;
    const int lb = wid & 3, hp = wid >> 2, l = 32 * lb + r32;
    const size_t row0 = (size_t)b * SEQ + c * 128, row = row0 + l;
    __syncthreads();
#pragma unroll 4
    for (int i = 0; i < 8; ++i) { const int idx = tid + 512 * i, ll = idx >> 5, c8 = idx & 31; const size_t off = (row0 + ll) * 2048 + 256 * g + 8 * c8;
        *(LAS u32x4*)(lds + S3_Y + ll * XN_PITCH + c8 * 16) = *(const u32x4*)(B.ypart + off);
        *(LAS u32x4*)(lds + S3_Z + ll * XN_PITCH + c8 * 16) = *(const u32x4*)(B.z + off); }
    bf16x8 cf[8];
#pragma unroll
    for (int k = 0; k < 8; ++k) cf[k] = *(const bf16x8*)(B.cc + row * 1024 + 128 * g + 16 * k + 8 * hi);
    const float ac0 = B.acum[row * 32 + 4 * g + 2 * hp], ac1 = B.acum[row * 32 + 4 * g + 2 * hp + 1];
    f32x16 y[2][2];
#pragma unroll
    for (int hh = 0; hh < 2; ++hh) {
        const int head = 4 * g + 2 * hp + hh;
        const bf16* hb = B.hprev + (((size_t)b * NCHUNK + c) * 32 + head) * 8192 + (size_t)r32 * 128 + 8 * hi;
#pragma unroll
        for (int pb = 0; pb < 2; ++pb) {
            f32x16 acc;
#pragma unroll
            for (int q = 0; q < 16; ++q) acc[q] = 0.f;
#pragma unroll
            for (int k = 0; k < 8; ++k) { const bf16x8 af = *(const bf16x8*)(hb + pb * 32 * 128 + 16 * k); acc = __builtin_amdgcn_mfma_f32_32x32x16_bf16(af, cf[k], acc, 0, 0, 0); }
            y[hh][pb] = acc;
        }
    }
    __syncthreads();
    float ss = 0.f;
#pragma unroll
    for (int hh = 0; hh < 2; ++hh) {
        const int r = 2 * hp + hh;
        const float ea = __expf(hh ? ac1 : ac0);
#pragma unroll
        for (int pb = 0; pb < 2; ++pb) {
            const int cl = 64 * r + 32 * pb + 4 * hi;
#pragma unroll
            for (int rg = 0; rg < 4; ++rg) {
                const u32x2 yp = *(const LAS u32x2*)(lds + S3_Y + l * XN_PITCH + (cl + 8 * rg) * 2), zz = *(const LAS u32x2*)(lds + S3_Z + l * XN_PITCH + (cl + 8 * rg) * 2);
                const float v0 = (bf_lo(yp.x) + ea * y[hh][pb][4 * rg]) * silu_f(bf_lo(zz.x)), v1 = (bf_hi(yp.x) + ea * y[hh][pb][4 * rg + 1]) * silu_f(bf_hi(zz.x));
                const float v2 = (bf_lo(yp.y) + ea * y[hh][pb][4 * rg + 2]) * silu_f(bf_lo(zz.y)), v3 = (bf_hi(yp.y) + ea * y[hh][pb][4 * rg + 3]) * silu_f(bf_hi(zz.y));
                y[hh][pb][4 * rg] = v0; y[hh][pb][4 * rg + 1] = v1; y[hh][pb][4 * rg + 2] = v2; y[hh][pb][4 * rg + 3] = v3;
                ss += (v0 * v0 + v1 * v1) + (v2 * v2 + v3 * v3);
            }
        }
    }
    ss += __shfl_xor(ss, 32);
    if (hi == 0) *(LAS float*)(lds + S3_TAB + (wid * 32 + r32) * 4) = ss;
    __syncthreads();
    const float tot = *(const LAS float*)(lds + S3_TAB + (wid * 32 + r32) * 4) + *(const LAS float*)(lds + S3_TAB + ((wid ^ 4) * 32 + r32) * 4);
    const float rs = rsqrtf(tot * (1.0f / 256.0f) + RMS_EPS);
#pragma unroll
    for (int hh = 0; hh < 2; ++hh)
#pragma unroll
        for (int pb = 0; pb < 2; ++pb) {
            const int cl = 64 * (2 * hp + hh) + 32 * pb + 4 * hi;
#pragma unroll
            for (int rg = 0; rg < 4; ++rg) {
                const f32x4 gg = *(const f32x4*)(B.ng + 256 * g + cl + 8 * rg);
                u32x2 w; w.x = cvt_pk(y[hh][pb][4 * rg] * rs * gg[0], y[hh][pb][4 * rg + 1] * rs * gg[1]); w.y = cvt_pk(y[hh][pb][4 * rg + 2] * rs * gg[2], y[hh][pb][4 * rg + 3] * rs * gg[3]);
                *(LAS u32x2*)(lds + S3_Y + l * XN_PITCH + (cl + 8 * rg) * 2) = w;
            }
        }
    __syncthreads();
#pragma unroll 4
    for (int i = 0; i < 8; ++i) { const int idx = tid + 512 * i, ll = idx >> 5, c8 = idx & 31;
        *(u32x4*)(B.yn + (row0 + ll) * 2048 + 256 * g + 8 * c8) = *(const LAS u32x4*)(lds + S3_Y + ll * XN_PITCH + c8 * 16); }
}
constexpr int S3W_PITCH = 144, S3W_TILE = 32 * S3W_PITCH, S3W_BYTES = 2 * S3W_TILE;
__device__ __forceinline__ void s3_wave_item(LAS unsigned char* wl, const Bufs& B, int witem, int lane) {
    const int r32 = lane & 31, hi = lane >> 5;
    const int lb = witem & 3, g = (witem >> 2) & 7, c = (witem >> 5) & 31, b = witem >> 10;
    const size_t row0 = (size_t)b * SEQ + c * 128 + 32 * lb, row = row0 + r32;
    LAS unsigned char* Yt = wl; LAS unsigned char* Zt = wl + S3W_TILE;
    bf16x8 cf[8];
#pragma unroll
    for (int k = 0; k < 8; ++k) cf[k] = *(const bf16x8*)(B.cc + row * 1024 + 128 * g + 16 * k + 8 * hi);
    const f32x4 ac4 = *(const f32x4*)(B.acum + row * 32 + 4 * g);
    unsigned yk[4][2][8]; float ss = 0.f;
    const int srow = lane >> 3, sch = lane & 7;
#pragma unroll
    for (int r = 0; r < 4; ++r) {
        const int head = 4 * g + r;
        const bf16* hb = B.hprev + (((size_t)b * NCHUNK + c) * 32 + head) * 8192 + (size_t)r32 * 128 + 8 * hi;
        u32x4 yl[4], zl[4];
#pragma unroll
        for (int i = 0; i < 4; ++i) { const size_t off = (row0 + srow + 8 * i) * 2048 + 256 * g + 64 * r + 8 * sch; yl[i] = *(const u32x4*)(B.ypart + off); zl[i] = *(const u32x4*)(B.z + off); }
        f32x16 accs[2];
#pragma unroll
        for (int pb = 0; pb < 2; ++pb) {
            f32x16 acc;
#pragma unroll
            for (int q = 0; q < 16; ++q) acc[q] = 0.f;
#pragma unroll
            for (int k = 0; k < 8; ++k) { const bf16x8 af = *(const bf16x8*)(hb + pb * 32 * 128 + 16 * k); acc = __builtin_amdgcn_mfma_f32_32x32x16_bf16(af, cf[k], acc, 0, 0, 0); }
            accs[pb] = acc;
        }
#pragma unroll
        for (int i = 0; i < 4; ++i) { *(LAS u32x4*)(Yt + (srow + 8 * i) * S3W_PITCH + sch * 16) = yl[i]; *(LAS u32x4*)(Zt + (srow + 8 * i) * S3W_PITCH + sch * 16) = zl[i]; }
        asm volatile("" ::: "memory");
        const float ea = __expf(ac4[r]);
#pragma unroll
        for (int pb = 0; pb < 2; ++pb)
#pragma unroll
            for (int rg = 0; rg < 4; ++rg) {
                const int cl = 32 * pb + 8 * rg + 4 * hi;
                const u32x2 yp = *(const LAS u32x2*)(Yt + r32 * S3W_PITCH + cl * 2), zz = *(const LAS u32x2*)(Zt + r32 * S3W_PITCH + cl * 2);
                const float v0 = (bf_lo(yp.x) + ea * accs[pb][4 * rg]) * silu_f(bf_lo(zz.x)), v1 = (bf_hi(yp.x) + ea * accs[pb][4 * rg + 1]) * silu_f(bf_hi(zz.x));
                const float v2 = (bf_lo(yp.y) + ea * accs[pb][4 * rg + 2]) * silu_f(bf_lo(zz.y)), v3 = (bf_hi(yp.y) + ea * accs[pb][4 * rg + 3]) * silu_f(bf_hi(zz.y));
                yk[r][pb][2 * rg] = cvt_pk(v0, v1); yk[r][pb][2 * rg + 1] = cvt_pk(v2, v3);
                ss += (v0 * v0 + v1 * v1) + (v2 * v2 + v3 * v3);
            }
        asm volatile("" ::: "memory");
    }
    ss += __shfl_xor(ss, 32);
    const float rs = rsqrtf(ss * (1.0f / 256.0f) + RMS_EPS);
#pragma unroll
    for (int r = 0; r < 4; ++r) {
        asm volatile("" ::: "memory");
#pragma unroll
        for (int pb = 0; pb < 2; ++pb)
#pragma unroll
            for (int rg = 0; rg < 4; ++rg) {
                const int cl = 32 * pb + 8 * rg + 4 * hi;
                const f32x4 gg = *(const f32x4*)(B.ng + 256 * g + 64 * r + cl);
                const unsigned p0 = yk[r][pb][2 * rg], p1 = yk[r][pb][2 * rg + 1];
                u32x2 w; w.x = cvt_pk(bf_lo(p0) * rs * gg[0], bf_hi(p0) * rs * gg[1]); w.y = cvt_pk(bf_lo(p1) * rs * gg[2], bf_hi(p1) * rs * gg[3]);
                *(LAS u32x2*)(Yt + r32 * S3W_PITCH + cl * 2) = w;
            }
        asm volatile("" ::: "memory");
#pragma unroll
        for (int i = 0; i < 4; ++i) *(u32x4*)(B.yn + (row0 + srow + 8 * i) * 2048 + 256 * g + 64 * r + 8 * sch) = *(const LAS u32x4*)(Yt + (srow + 8 * i) * S3W_PITCH + sch * 16);
    }
}
__device__ __forceinline__ void s3_phase(LAS unsigned char* lds, const Bufs& B) {
    const int tid = tid_l(), lane = tid & 63; const int wid = __builtin_amdgcn_readfirstlane(tid >> 6);
    LAS unsigned char* wl = lds + wid * S3W_BYTES;
    for (int wit = blockIdx.x * 8 + wid; wit < NB * NCHUNK * 8 * 4; wit += gridDim.x * 8) s3_wave_item(wl, B, wit, lane);
}
}
#define XB_TMO      128
#define XB_XCNT(j)  (256  + 64 * (j))
#define XB_XSUB(j)  (1280 + 64 * (j))
#define XB_XGEN(j)  (2304 + 64 * (j))
#define XB_TOP      3328
#define XB_TOPGEN   3392
#define XCD_BAR_WORDS 3456
#define XB_SPIN_CAP (1u << 18)

__device__ __forceinline__ unsigned xb_ld(unsigned* p)              { return __hip_atomic_load(p, __ATOMIC_RELAXED, __HIP_MEMORY_SCOPE_AGENT); }
__device__ __forceinline__ unsigned xb_add(unsigned* p, unsigned v) { return __hip_atomic_fetch_add(p, v, __ATOMIC_RELAXED, __HIP_MEMORY_SCOPE_AGENT); }
__device__ __forceinline__ unsigned xb_xcc_id() { return (unsigned)__builtin_amdgcn_s_getreg((3 << 11) | 20) & 0xFu; }
#define XB_SPIN(cond, bar) do { unsigned _sp = 0; while (cond) { __builtin_amdgcn_s_sleep(1); \
    if ((++_sp & 255u) == 0u) { if (xb_ld(&(bar)[XB_TMO])) break; if (_sp > XB_SPIN_CAP) { atomicAdd(&(bar)[XB_TMO], 1u); break; } } } } while (0)

struct XcdBarrier {
    unsigned* bar; unsigned x;
    volatile LAS unsigned* st;
};

__device__ __forceinline__ XcdBarrier xcd_barrier_post(unsigned* bar, volatile LAS unsigned* st) {
    XcdBarrier b; b.bar = bar; b.x = xb_xcc_id(); b.st = st;
    if (threadIdx.x == 0) (void)xb_add(&bar[XB_XCNT(b.x)], 1u);
    return b;
}
__device__ __forceinline__ void xcd_barrier_complete(unsigned* bar, unsigned x, unsigned& nloc, unsigned& nx) {
    const unsigned G = gridDim.x * gridDim.y * gridDim.z;
    unsigned sum, cnt, mine, sp = 0u;
    for (;;) {
        sum = 0u; cnt = 0u; mine = 0u;
#pragma unroll
        for (unsigned j = 0; j < 16; ++j) { const unsigned c = xb_ld(&bar[XB_XCNT(j)]); sum += c; cnt += (c > 0u) ? 1u : 0u; mine = (j == x) ? c : mine; }
        if (sum == G) break;
        __builtin_amdgcn_s_sleep(1);
        if ((++sp & 255u) == 0u) { if (xb_ld(&bar[XB_TMO])) break; if (sp > XB_SPIN_CAP) { atomicAdd(&bar[XB_TMO], 1u); break; } }
    }
    nloc = mine > 0u ? mine : 1u; nx = cnt > 0u ? cnt : 1u;
}

__device__ __forceinline__ void xcd_barrier(const XcdBarrier& b) {
    asm volatile("s_waitcnt vmcnt(0)" ::: "memory");
    __syncthreads();
    if (threadIdx.x == 0) {
        unsigned* bar = b.bar;
        __builtin_amdgcn_s_waitcnt(0);
        unsigned nloc = b.st[0], nx = b.st[1];
        if (nloc == 0u) { xcd_barrier_complete(bar, b.x, nloc, nx); b.st[0] = nloc; b.st[1] = nx; }
        const unsigned old = xb_add(&bar[XB_XSUB(b.x)], 1u);
        const unsigned gen = old / nloc;
        if (old + 1u == (gen + 1u) * nloc) {
            __builtin_amdgcn_fence(__ATOMIC_RELEASE, "agent");
            asm volatile("s_waitcnt vmcnt(0)" ::: "memory");
            const unsigned og = xb_add(&bar[XB_TOP], 1u);
            const unsigned tg = og / nx;
            if (og + 1u == (tg + 1u) * nx) xb_add(&bar[XB_TOPGEN], 1u);
            else XB_SPIN(xb_ld(&bar[XB_TOPGEN]) == tg, bar);
            __builtin_amdgcn_fence(__ATOMIC_ACQUIRE, "agent");
            xb_add(&bar[XB_XGEN(b.x)], 1u);
            asm volatile("s_waitcnt vmcnt(0)" ::: "memory");
        } else {
            XB_SPIN(xb_ld(&bar[XB_XGEN(b.x)]) == gen, bar);
            __builtin_amdgcn_fence(__ATOMIC_ACQUIRE, "agent");
            asm volatile("s_waitcnt vmcnt(0)" ::: "memory");
        }
    }
    __syncthreads();
}


__global__ void __launch_bounds__(512, 2) hybrid_fwd(Args a) {
    extern __shared__ __attribute__((aligned(16))) unsigned char lds_raw[];
    LAS unsigned char* lds = (LAS unsigned char*)lds_raw;
    cg::grid_group grid = cg::this_grid();
    volatile LAS unsigned* bst = (volatile LAS unsigned*)(lds + LDS_BYTES - 16);
    { const ArgsP a0 = get_args(); unsigned* bw = (unsigned*)(a0->ws + WS_BAR);
      if (tid_l() < 2) bst[tid_l()] = 0u;
      if (tid_l() == 0) (void)xb_add(bw + XB_XCNT(xb_xcc_id()), 1u);
      if (a0->ws == nullptr) grid.sync(); }
#define XSYNC() do { XcdBarrier xbar_; xbar_.bar = (unsigned*)(get_args()->ws + WS_BAR); xbar_.x = xb_xcc_id(); xbar_.st = bst; xcd_barrier(xbar_); } while (0)
#define GRID_SYNC() do { asm volatile("s_waitcnt vmcnt(0) lgkmcnt(0)" ::: "memory"); grid.sync(); __builtin_amdgcn_fence(__ATOMIC_ACQUIRE, "agent"); asm volatile("s_waitcnt vmcnt(0)" ::: "memory"); } while (0)
#define TAIL_CONVERT(NWG, LYR, MASK) do { const int rem_ = (NWG) % G; if (rem_ == 0) convert_layer(get_args(), (LYR), lds, (MASK), bx, G); else if (bx >= rem_) convert_layer(get_args(), (LYR), lds, (MASK), bx - rem_, G - rem_); } while (0)
#pragma unroll 1
    for (int step = 0; step < MAXSTEP; ++step) {
        const int layer = step >> 3, k = step & 7, kind = layer % 3;
        if (k == 0 && layer > 0) continue;
        const ArgsP a = get_args();
        unsigned char* ws = a->ws; float* rsp = (float*)(ws + WS_RSP); bf16* xb = (bf16*)(ws + WS_XB); bf16* ar = (bf16*)(ws + WS_AR);
        const int G = gridDim.x, bx = blockIdx.x;
#ifdef REPEAT_MASK
        const int nrep = (((REPEAT_MASK >> k) & 1) && !(k == 4 && kind == 1)) ? 2 : 1;
#else
        const int nrep = 1;
#endif
#pragma unroll 1
        for (int rep = 0; rep < nrep; ++rep) {
        const float alpha_mul = (rep + 1 == nrep) ? 1.0f : 0.0f;
        if (k == 0) {
#if !defined(NO_P0)
            if (layer == 0) init_rows(a);
            convert_layer(a, layer, lds, 63, bx, G);
#endif
        } else if (k == 1 || k == 6) {
            pg8::Gemm g{xb, (const bf16*)(ws + (k == 1 ? W_GU1 : W_GU2)), T, 2 * FF, DM}; pg8::StaticOrder S; S.init(T, 2 * FF, G, bx);
            pg8::EpiSwiGLU E{ar, rsp, FF};
#if !defined(NO_G1)
            pg8::gemm_phase<pg8::EpiSwiGLU, pg8::StaticOrder, true, true>(lds, g, S, E);
#endif
            if (k == 1 && layer > 0) TAIL_CONVERT((T / 256) * (2 * FF / 256), layer, 2 | 8);
            if (k == 6 && layer + 1 < DEPTH) TAIL_CONVERT((T / 256) * (2 * FF / 256), layer + 1, (kind == 1) ? (16 | 32) : (1 | 4 | 16 | 32));
        } else if (k == 2 || k == 7) {
            pg8::Gemm g{ar, (const bf16*)(ws + (k == 2 ? W_D1 : W_D2)), T, DM, FF}; pg8::StaticOrder S; S.init(T, DM, G, bx);
            pg8::EpiResid E{xb, rsp, 0.5f * alpha_mul};
#if !defined(NO_G2)
            pg8::gemm_phase<pg8::EpiResid, pg8::StaticOrder, true, true>(lds, g, S, E);
#endif
        } else if (k == 3) {
            const int n = (kind == 1) ? SSD_IN_PAD : 3 * DM;
            pg8::Gemm g{xb, (const bf16*)(ws + W_IN), T, n, DM}; pg8::StaticOrder S; S.init(T, n, G, bx);
            pg8::EpiSplit E;
            if (kind == 1) E = pg8::EpiSplit{ar, 2048, 8, (size_t)T * 2048, rsp, 1.0f, (float*)(ws + WS_DT), 24};
            else E = pg8::EpiSplit{ar, 1024, 4, (size_t)T * 1024, rsp, (kind == 0) ? SB_C2 : 1.0f, nullptr, -1};
#if !defined(NO_G3)
            pg8::gemm_phase<pg8::EpiSplit, pg8::StaticOrder, true, true>(lds, g, S, E);
#endif
            if (kind == 1 && layer + 1 < DEPTH) TAIL_CONVERT((T / 256) * (SSD_IN_PAD / 256), layer + 1, 1 | 4);
        } else if (k == 4) {
            if (kind == 0) {
#if !defined(NO_SBA)
                sba::phase(lds, ar, ar + (size_t)T * 1024, ar + (size_t)2 * T * 1024, ar + (size_t)3 * T * 1024);
#endif
            } else if (kind == 1) {
                ssd::Bufs B;
                B.z = ar; B.xs_raw = ar + (size_t)T * 2048; B.bc_raw = ar + (size_t)2 * T * 2048; B.ypart = ar + (size_t)3 * T * 2048; B.states = ar + (size_t)4 * T * 2048;
                B.hprev = ar + (size_t)T * 2048; B.yn = ar + (size_t)4 * T * 2048; B.cc = (bf16*)a->out;
                B.dt_raw = (const float*)(ws + WS_DT); B.acum = (float*)(ws + WS_ACUM); B.alast = (float*)(ws + WS_ALAST);
                B.conv_w = a->in[11]; B.conv_b = a->in[12]; B.dt_bias = a->in[13]; B.a_log = a->in[14]; B.dsk = a->in[15]; B.ng = a->in[16];
#if !defined(NO_S1)
                for (int it = bx; it < NB * NCHUNK * 8; it += G) ssd::s1_item(lds, B, it);
#endif
                XSYNC();
#if !defined(NO_S2)
                ssd::s2_phase(B);
#endif
                XSYNC();
#if !defined(NO_S3)
                ssd::s3_phase(lds, B);
#endif
            } else {
#if !defined(NO_SC)
                shortconv_phase(ar, ar + (size_t)T * 1024, ar + (size_t)2 * T * 1024, a->in[19] + (size_t)(layer / 3) * 3 * DM, ar + (size_t)3 * T * 1024);
#endif
            }
        } else {
            const int kk = (kind == 1) ? 2 * DM : DM;
#ifdef DBG_AZ
            const bf16* A = (kind == 1) ? ar + (size_t)DBG_AZ * T * 2048 : ar + (size_t)3 * T * 1024;
#else
            const bf16* A = (kind == 1) ? ar + (size_t)4 * T * 2048 : ar + (size_t)3 * T * 1024;
#endif
            pg8::Gemm g{A, (const bf16*)(ws + W_OUT), T, DM, kk}; pg8::StaticOrder S; S.init(T, DM, G, bx);
            pg8::EpiResid E{xb, rsp, alpha_mul};
#if !defined(NO_G4)
            pg8::gemm_phase<pg8::EpiResid, pg8::StaticOrder, true, true>(lds, g, S, E);
#endif
        }
        XSYNC();
#ifdef REPEAT_SYNC
        XSYNC();
#endif
        }
    }
    final_norm(get_args());
}

extern "C" void kernel_launch(void* const* d_in, const int* in_sizes, int n_in, void* d_out, int out_size, void* d_ws, size_t ws_size, hipStream_t stream) {
    static int grid = 0;
    if (grid == 0) {
        if (n_in != 22 || out_size != T * DM || ws_size < WS_END) { fprintf(stderr, "kernel_launch: unexpected shapes: n_in %d out %d ws %zu (need %zu)\n", n_in, out_size, ws_size, (size_t)WS_END); grid = -1; return; }
        int dev = 0, cus = 0, per_cu = 0;
        hipGetDevice(&dev); hipDeviceGetAttribute(&cus, hipDeviceAttributeMultiprocessorCount, dev);
        if (hipFuncSetAttribute((const void*)hybrid_fwd, hipFuncAttributeMaxDynamicSharedMemorySize, LDS_BYTES) != hipSuccess) { fprintf(stderr, "kernel_launch: hipFuncSetAttribute failed\n"); grid = -1; return; }
        if (hipOccupancyMaxActiveBlocksPerMultiprocessor(&per_cu, (const void*)hybrid_fwd, 512, LDS_BYTES) != hipSuccess || per_cu < 1) { fprintf(stderr, "kernel_launch: occupancy query gave %d\n", per_cu); per_cu = 1; }
        (void)hipGetLastError();
        grid = cus * per_cu;
        fprintf(stderr, "kernel_launch: grid %d (%d CUs x %d)\n", grid, cus, per_cu);
    }
    if (grid < 0) return;
    Args a{};
    for (int i = 0; i < 22; ++i) a.in[i] = (const float*)d_in[i];
    a.out = (float*)d_out; a.ws = (unsigned char*)d_ws;
    if (hipMemsetAsync((char*)d_ws + WS_BAR, 0, XCD_BAR_WORDS * 4, stream) != hipSuccess) { fprintf(stderr, "kernel_launch: hipMemsetAsync failed\n"); return; }
    void* args[] = {&a};
    hipError_t e = hipLaunchCooperativeKernel((const void*)hybrid_fwd, dim3(grid), dim3(512), args, LDS_BYTES, stream);
    if (e != hipSuccess) fprintf(stderr, "kernel_launch: cooperative launch failed: %s (grid %d)\n", hipGetErrorString(e), grid);
}
```

```cpp
#include <hip/hip_runtime.h>
#include <hip/hip_cooperative_groups.h>
#include <cstdio>
#include <cstdint>
namespace cg = cooperative_groups;
__device__ __forceinline__ int tid_l() { int t = threadIdx.x; asm volatile("" : "+v"(t)); return t; }
namespace pg8 {
#define PG8_LAS __attribute__((address_space(3)))
typedef unsigned short bf16_t;
typedef short bf16x8 __attribute__((ext_vector_type(8)));
typedef float f32x4 __attribute__((ext_vector_type(4)));
typedef unsigned u32x4 __attribute__((ext_vector_type(4)));
constexpr int BM = 256, BK = 64, HALF = 128, HTB = HALF * BK * 2  , STAGE_BYTES = 8 * HTB, NXCD = 8, WGM = 8;

__host__ __device__ __forceinline__ int lds_byte(int r, int c) { const int st = (r >> 4) * 2 + (c >> 5), rr = r & 15, cc = c & 31, ob = rr * 64 + cc * 2; return st * 1024 + (ob ^ (((ob >> 9) & 1) << 5)); }
__host__ __device__ __forceinline__ void stage_rc(int b, int& R, int& C) { const int st = b / 1024, sb = b % 1024, swz = sb ^ (((sb >> 9) & 1) << 5); R = (st >> 1) * 16 + swz / 64; C = (st & 1) * 32 + (swz % 64) / 2; }
__host__ __device__ __forceinline__ int perm32(int rho) { const int n = rho >> 4, i = rho & 15; return 8 * (i >> 2) + 4 * n + (i & 3); }

struct Unit { int pm, pn; };
struct Gemm { const bf16_t* A; const bf16_t* Bt; int M, N, K; };

struct StaticOrder {
    int nM, nN, nwg, G, c;
    __host__ __device__ void init(int M, int N, int G_, int c_) { nM = M / BM; nN = N / BM; nwg = nM * nN; G = G_; c = c_; }
    __host__ __device__ bool next(int i, Unit& u) const {
        const long L = (long)i * G + c; if (L >= nwg) return false;
        int wgid = (int)L; { const int q = nwg / NXCD, r = nwg % NXCD, xcd = wgid % NXCD, off = wgid / NXCD; wgid = (xcd < r ? xcd * (q + 1) : r * (q + 1) + (xcd - r) * q) + off; }
        const int nig = WGM * nN, gid = wgid / nig, fm = gid * WGM, gsz = (nM - fm) < WGM ? (nM - fm) : WGM;
        u.pm = fm + ((wgid % nig) % gsz); u.pn = (wgid % nig) / gsz; return true;
    }
    __device__ __forceinline__ void a_ready(const Unit&) const {}
    __device__ __forceinline__ void done(const Unit&) const {}
};

typedef float f32x2_cv __attribute__((ext_vector_type(2))); typedef __bf16 bf16x2_cv __attribute__((ext_vector_type(2)));
__device__ __forceinline__ unsigned cvt_pk_bf16(float lo, float hi) { f32x2_cv v = {lo, hi}; bf16x2_cv b = __builtin_convertvector(v, bf16x2_cv); return __builtin_bit_cast(unsigned, b); }
template <class Epi, class Sched, bool ALIGN_EPI = false, bool SP2 = false>
__device__ __forceinline__ void gemm_phase(PG8_LAS unsigned char* lds, const Gemm g, const Sched& S, const Epi& E) {
    const int tid = tid_l(), wid = __builtin_amdgcn_readfirstlane(tid >> 6), lane = tid & 63, wr = wid >> 2, wc = wid & 3, fr = lane & 15, fq = lane >> 4;
    const int K = g.K, nt = K / BK;
    unsigned voffA[2], voffB[2];
#pragma unroll
    for (int i = 0; i < 2; ++i) { int R, C; stage_rc(tid * 16 + i * 8192, R, C); const int Rb = Epi::PERM ? ((R & ~31) + perm32(R & 31)) : R;
        voffA[i] = (unsigned)(R * K + C) * 2u; voffB[i] = (unsigned)(Rb * K + C) * 2u; }
    const size_t kstep = (size_t)(BK * 2);
    const size_t hstep = (size_t)HALF * K * 2;
    const size_t tstep = 2 * hstep;
    const unsigned ldsw = (unsigned)wid * 1024u;
    const int aoff = lds_byte(wr * 64 + fr, fq * 8), boff = lds_byte(wc * 32 + fr, fq * 8);
#define PG8_SA(b, h) (((b) * 2 + (h)) * HTB)
#define PG8_SB(b, h) ((4 + (b) * 2 + (h)) * HTB)
#define PG8_STAGE(bufoff, gbase, voff) do { _Pragma("unroll") for (int _i = 0; _i < 2; ++_i) \
        __builtin_amdgcn_global_load_lds((const unsigned*)((const char*)(gbase) + (voff)[_i]), (PG8_LAS unsigned*)(lds + (bufoff) + ldsw + _i * 8192), 16, 0, 0); } while (0)
#define PG8_LDA(dst, b, h) do { _Pragma("unroll") for (int m = 0; m < 4; ++m) _Pragma("unroll") for (int k = 0; k < 2; ++k) dst[m][k] = *(const PG8_LAS bf16x8*)(lds + PG8_SA(b, h) + aoff + m * 2048 + k * 1024); } while (0)
#define PG8_LDB(dst, b, h) do { _Pragma("unroll") for (int n = 0; n < 2; ++n) _Pragma("unroll") for (int k = 0; k < 2; ++k) dst[n][k] = *(const PG8_LAS bf16x8*)(lds + PG8_SB(b, h) + boff + n * 2048 + k * 1024); } while (0)
#define PG8_MMA(ai, bj, At, Bt) do { __builtin_amdgcn_s_setprio(1); _Pragma("unroll") for (int m = 0; m < 4; ++m) _Pragma("unroll") for (int n = 0; n < 2; ++n) _Pragma("unroll") for (int k = 0; k < 2; ++k) \
        acc[ai][bj][m][n] = __builtin_amdgcn_mfma_f32_16x16x32_bf16(Bt[n][k], At[m][k], acc[ai][bj][m][n], 0, 0, 0); __builtin_amdgcn_s_setprio(0); } while (0)
#define PG8_WAIT_V(n) asm volatile("s_waitcnt vmcnt(" #n ")" ::: "memory")
#define PG8_WAIT_L(n) asm volatile("s_waitcnt lgkmcnt(" #n ")" ::: "memory")
#define PG8_BAR __builtin_amdgcn_s_barrier()
#define PG8_SCHED __builtin_amdgcn_sched_barrier(0)
    Unit cur, nxt; int ui = 0;
    if (!S.next(0, cur)) return;
    f32x4 acc[2][2][4][2];
#pragma unroll
    for (int a = 0; a < 2; ++a)
#pragma unroll
        for (int b = 0; b < 2; ++b)
#pragma unroll
            for (int m = 0; m < 4; ++m)
#pragma unroll
                for (int n = 0; n < 2; ++n) acc[a][b][m][n] = (f32x4){0.f, 0.f, 0.f, 0.f};
    bf16x8 At[4][2], B0[2][2], B1[2][2];
    const char* cA = (const char*)g.A + (size_t)cur.pm * tstep; const char* cB = (const char*)g.Bt + (size_t)cur.pn * tstep;
    S.a_ready(cur);
    if constexpr (SP2) {
        PG8_STAGE(PG8_SB(0, 0), cB, voffB); PG8_STAGE(PG8_SB(0, 1), cB + hstep, voffB); PG8_STAGE(PG8_SA(0, 0), cA, voffA); PG8_STAGE(PG8_SA(0, 1), cA + hstep, voffA);
        if (wr == 1) PG8_BAR;
        PG8_WAIT_V(2); PG8_BAR;
        PG8_STAGE(PG8_SB(1, 0), cB + kstep, voffB); PG8_STAGE(PG8_SA(1, 0), cA + kstep, voffA); PG8_STAGE(PG8_SB(1, 1), cB + hstep + kstep, voffB);
        PG8_WAIT_V(6); PG8_BAR;
    } else {
        PG8_STAGE(PG8_SB(0, 0), cB, voffB); PG8_STAGE(PG8_SA(0, 0), cA, voffA); PG8_STAGE(PG8_SB(0, 1), cB + hstep, voffB); PG8_STAGE(PG8_SA(0, 1), cA + hstep, voffA);
        if (wr == 1) PG8_BAR;
        PG8_WAIT_V(4); PG8_BAR;
        PG8_STAGE(PG8_SB(1, 0), cB + kstep, voffB); PG8_STAGE(PG8_SA(1, 0), cA + kstep, voffA); PG8_STAGE(PG8_SB(1, 1), cB + hstep + kstep, voffB);
        PG8_WAIT_V(6); PG8_BAR;
    }
    for (;;) {
        const bool has_next = S.next(ui + 1, nxt);
        const char* nA = has_next ? (const char*)g.A + (size_t)nxt.pm * tstep : cA; const char* nB = has_next ? (const char*)g.Bt + (size_t)nxt.pn * tstep : cB;
        for (int t = 0; t < nt; t += 2) {
            const bool last = (t == nt - 2);
            const char* a1 = cA + (size_t)(t + 1) * kstep;
            const char* a2 = last ? nA : cA + (size_t)(t + 2) * kstep; const char* b2 = last ? nB : cB + (size_t)(t + 2) * kstep;
            const char* a3 = a2 + kstep; const char* b3 = b2 + kstep;
            if (last && has_next) S.a_ready(nxt);
            if constexpr (SP2) {
            PG8_LDB(B0, 0, 0); PG8_LDB(B1, 0, 1); PG8_SCHED; PG8_LDA(At, 0, 0); PG8_STAGE(PG8_SA(1, 1), a1 + hstep, voffA);
            PG8_WAIT_V(8); PG8_WAIT_L(0); PG8_BAR; PG8_MMA(0, 0, At, B0); PG8_MMA(0, 1, At, B1); PG8_BAR; PG8_SCHED;
            PG8_LDA(At, 0, 1); PG8_STAGE(PG8_SB(0, 0), b2, voffB); PG8_STAGE(PG8_SB(0, 1), b2 + hstep, voffB); PG8_STAGE(PG8_SA(0, 0), a2, voffA);
            PG8_WAIT_V(8); PG8_WAIT_L(0); PG8_BAR; PG8_MMA(1, 0, At, B0); PG8_MMA(1, 1, At, B1); PG8_BAR; PG8_SCHED;
            PG8_LDB(B0, 1, 0); PG8_LDB(B1, 1, 1); PG8_SCHED; PG8_LDA(At, 1, 0); PG8_STAGE(PG8_SA(0, 1), a2 + hstep, voffA);
            PG8_WAIT_V(8); PG8_WAIT_L(0); PG8_BAR; PG8_MMA(0, 0, At, B0); PG8_MMA(0, 1, At, B1); PG8_BAR; PG8_SCHED;
            PG8_LDA(At, 1, 1); PG8_STAGE(PG8_SB(1, 0), b3, voffB); PG8_STAGE(PG8_SB(1, 1), b3 + hstep, voffB); PG8_STAGE(PG8_SA(1, 0), a3, voffA);
            PG8_WAIT_V(8); PG8_WAIT_L(0); PG8_BAR; PG8_MMA(1, 0, At, B0); PG8_MMA(1, 1, At, B1); PG8_BAR; PG8_SCHED;
            } else {
            PG8_LDB(B0, 0, 0); PG8_SCHED; PG8_LDA(At, 0, 0); PG8_STAGE(PG8_SA(1, 1), a1 + hstep, voffA);
            PG8_WAIT_L(8); PG8_BAR; PG8_WAIT_L(0); PG8_MMA(0, 0, At, B0); PG8_BAR; PG8_SCHED;
            PG8_LDB(B1, 0, 1); PG8_STAGE(PG8_SB(0, 0), b2, voffB);
            PG8_BAR; PG8_WAIT_L(0); PG8_MMA(0, 1, At, B1); PG8_BAR;
            PG8_LDA(At, 0, 1); PG8_STAGE(PG8_SA(0, 0), a2, voffA);
            PG8_BAR; PG8_WAIT_L(0); PG8_MMA(1, 0, At, B0); PG8_BAR; PG8_SCHED;
            PG8_STAGE(PG8_SB(0, 1), b2 + hstep, voffB);
            PG8_WAIT_V(6); PG8_BAR; PG8_MMA(1, 1, At, B1); PG8_BAR;
            PG8_LDB(B0, 1, 0); PG8_SCHED; PG8_LDA(At, 1, 0); PG8_STAGE(PG8_SA(0, 1), a2 + hstep, voffA);
            PG8_WAIT_L(8); PG8_BAR; PG8_WAIT_L(0); PG8_MMA(0, 0, At, B0); PG8_BAR; PG8_SCHED;
            PG8_LDB(B1, 1, 1); PG8_STAGE(PG8_SB(1, 0), b3, voffB);
            PG8_BAR; PG8_WAIT_L(0); PG8_MMA(0, 1, At, B1); PG8_BAR;
            PG8_LDA(At, 1, 1); PG8_STAGE(PG8_SA(1, 0), a3, voffA);
            PG8_BAR; PG8_WAIT_L(0); PG8_MMA(1, 0, At, B0); PG8_BAR; PG8_SCHED;
            PG8_STAGE(PG8_SB(1, 1), b3 + hstep, voffB);
            PG8_WAIT_V(6); PG8_BAR; PG8_MMA(1, 1, At, B1); PG8_BAR;
            }
        }
        if constexpr (ALIGN_EPI) { if (wr == 0) PG8_BAR; }
        if constexpr (!Epi::AFTER_DRAIN) { E(acc, cur, wr, wc, fr, fq); S.done(cur); }
        if (!has_next) break;
#pragma unroll
        for (int a = 0; a < 2; ++a)
#pragma unroll
            for (int b = 0; b < 2; ++b)
#pragma unroll
                for (int m = 0; m < 4; ++m)
#pragma unroll
                    for (int n = 0; n < 2; ++n) acc[a][b][m][n] = (f32x4){0.f, 0.f, 0.f, 0.f};
        cur = nxt; cA = nA; cB = nB; ++ui;
        if constexpr (ALIGN_EPI) { if (wr == 1) PG8_BAR; }
    }
    PG8_WAIT_V(0);
    if constexpr (!ALIGN_EPI) { if (wr == 0) PG8_BAR; }
    PG8_BAR;
    if constexpr (Epi::AFTER_DRAIN) { E.fused(acc, cur, wr, wc, fr, fq, lds, wid, lane); S.done(cur); }
#undef PG8_SA
#undef PG8_SB
#undef PG8_STAGE
#undef PG8_LDA
#undef PG8_LDB
#undef PG8_MMA
#undef PG8_WAIT_V
#undef PG8_WAIT_L
#undef PG8_BAR
#undef PG8_SCHED
}
}
namespace pg8 {
typedef unsigned u32x2 __attribute__((ext_vector_type(2)));
constexpr float RMS_EPS = 1e-6f;
constexpr float LOG2E = 1.4426950408889634f;
__device__ __forceinline__ float silu_f(float x) { return x * __builtin_amdgcn_rcpf(1.0f + __builtin_amdgcn_exp2f(-x * LOG2E)); }
__device__ __forceinline__ float row_rstd(const float* rsp, int row, int fq) {
    const f32x4 v = *(const f32x4*)(rsp + (size_t)row * 16 + 4 * fq);
    float s = (v[0] + v[1]) + (v[2] + v[3]); s += __shfl_xor(s, 16); s += __shfl_xor(s, 32);
    return rsqrtf(s * (1.0f / 1024.0f) + RMS_EPS);
}
struct EpiSwiGLU {
    static constexpr bool PERM = true, AFTER_DRAIN = false;
    bf16_t* O; const float* rsp; int ldc;
    __device__ __forceinline__ void operator()(const f32x4 (&acc)[2][2][4][2], const Unit& u, int wr, int wc, int fr, int fq) const {
        const int row0 = u.pm * BM + wr * 64 + fr, col0 = u.pn * HALF + wc * 32 + 8 * fq;
#pragma unroll
        for (int ai = 0; ai < 2; ++ai)
#pragma unroll
            for (int m = 0; m < 4; ++m) {
                const int row = row0 + ai * HALF + m * 16; const float rs = row_rstd(rsp, row, fq);
                const float nrs = -LOG2E * rs, rs2 = rs * rs;
                const f32x4 g0 = acc[ai][0][m][0], g1 = acc[ai][0][m][1], u0 = acc[ai][1][m][0], u1 = acc[ai][1][m][1];
                const f32x4 a0 = g0 * nrs, a1 = g1 * nrs;
                f32x4 e0, e1;
#pragma unroll
                for (int q = 0; q < 4; ++q) { e0[q] = __builtin_amdgcn_exp2f(a0[q]); e1[q] = __builtin_amdgcn_exp2f(a1[q]); }
                const f32x4 d0 = e0 + 1.0f, d1 = e1 + 1.0f;
                f32x4 r0, r1;
#pragma unroll
                for (int q = 0; q < 4; ++q) { r0[q] = __builtin_amdgcn_rcpf(d0[q]); r1[q] = __builtin_amdgcn_rcpf(d1[q]); }
                const f32x4 o0 = ((g0 * u0) * rs2) * r0, o1 = ((g1 * u1) * rs2) * r1;
                u32x4 w; w.x = cvt_pk_bf16(o0[0], o0[1]); w.y = cvt_pk_bf16(o0[2], o0[3]); w.z = cvt_pk_bf16(o1[0], o1[1]); w.w = cvt_pk_bf16(o1[2], o1[3]);
                *(u32x4*)(O + (size_t)row * ldc + col0) = w;
            }
    }
};
struct EpiSplit {
    static constexpr bool PERM = true, AFTER_DRAIN = false;
    bf16_t* O; int ldc; int tiles_per_split; size_t split_stride; const float* rsp; float scale0; float* dt_out; int dt_tile;
    __device__ __forceinline__ void operator()(const f32x4 (&acc)[2][2][4][2], const Unit& u, int wr, int wc, int fr, int fq) const {
        const int row0 = u.pm * BM + wr * 64 + fr;
        if (u.pn == dt_tile) {
            if (wc == 0) {
#pragma unroll
                for (int ai = 0; ai < 2; ++ai)
#pragma unroll
                    for (int m = 0; m < 4; ++m) {
                        const int row = row0 + ai * HALF + m * 16; const float rs = row_rstd(rsp, row, fq);
#pragma unroll
                        for (int n = 0; n < 2; ++n) *(f32x4*)(dt_out + (size_t)row * 32 + 8 * fq + 4 * n) = acc[ai][0][m][n] * rs;
                    }
            } else {
#pragma unroll
                for (int ai = 0; ai < 2; ++ai)
#pragma unroll
                    for (int m = 0; m < 4; ++m) (void)row_rstd(rsp, row0 + ai * HALF + m * 16, fq);
            }
            return;
        }
        const int t = u.pn / tiles_per_split; bf16_t* base = O + (size_t)t * split_stride; const int colt = (u.pn - t * tiles_per_split) * BM + wc * 32 + 8 * fq;
        const float sc = (t == 0) ? scale0 : 1.0f;
#pragma unroll
        for (int ai = 0; ai < 2; ++ai)
#pragma unroll
            for (int m = 0; m < 4; ++m) {
                const int row = row0 + ai * HALF + m * 16; const float rs = row_rstd(rsp, row, fq) * sc;
                bf16_t* rowp = base + (size_t)row * ldc + colt;
#pragma unroll
                for (int bj = 0; bj < 2; ++bj) {
                    const f32x4 v0 = acc[ai][bj][m][0] * rs, v1 = acc[ai][bj][m][1] * rs;
                    u32x4 w; w.x = cvt_pk_bf16(v0[0], v0[1]); w.y = cvt_pk_bf16(v0[2], v0[3]); w.z = cvt_pk_bf16(v1[0], v1[1]); w.w = cvt_pk_bf16(v1[2], v1[3]);
                    *(u32x4*)(rowp + bj * HALF) = w;
                }
            }
    }
};
struct EpiResid {
    static constexpr bool PERM = true, AFTER_DRAIN = false;
    bf16_t* XB; float* rsp_out; float alpha;
    __device__ __forceinline__ void operator()(const f32x4 (&acc)[2][2][4][2], const Unit& u, int wr, int wc, int fr, int fq) const {
        const int row0 = u.pm * BM + wr * 64 + fr, col0 = u.pn * BM + wc * 32 + 8 * fq;
#pragma unroll
        for (int ai = 0; ai < 2; ++ai) {
            u32x4 xv[4][2];
#pragma unroll
            for (int m = 0; m < 4; ++m)
#pragma unroll
                for (int bj = 0; bj < 2; ++bj) xv[m][bj] = *(const u32x4*)(XB + (size_t)(row0 + ai * HALF + m * 16) * 1024 + col0 + bj * HALF);
            asm volatile("" ::: "memory");
#pragma unroll
            for (int m = 0; m < 4; ++m) {
                const int row = row0 + ai * HALF + m * 16; float ss = 0.f;
#pragma unroll
                for (int bj = 0; bj < 2; ++bj) {
                    const size_t off = (size_t)row * 1024 + col0 + bj * HALF;
                    const u32x4 v = xv[m][bj];
                    f32x4 x0 = {__uint_as_float(v.x << 16), __uint_as_float(v.x & 0xffff0000u), __uint_as_float(v.y << 16), __uint_as_float(v.y & 0xffff0000u)};
                    f32x4 x1 = {__uint_as_float(v.z << 16), __uint_as_float(v.z & 0xffff0000u), __uint_as_float(v.w << 16), __uint_as_float(v.w & 0xffff0000u)};
                    x0 = x0 + acc[ai][bj][m][0] * alpha; x1 = x1 + acc[ai][bj][m][1] * alpha;
                    u32x4 w; w.x = cvt_pk_bf16(x0[0], x0[1]); w.y = cvt_pk_bf16(x0[2], x0[3]); w.z = cvt_pk_bf16(x1[0], x1[1]); w.w = cvt_pk_bf16(x1[2], x1[3]);
                    *(u32x4*)(XB + off) = w;
                    const f32x4 sq = x0 * x0 + x1 * x1;
                    ss += (sq[0] + sq[1]) + (sq[2] + sq[3]);
                }
                ss += __shfl_xor(ss, 16); ss += __shfl_xor(ss, 32);
                if (fq == 0) rsp_out[(size_t)row * 16 + u.pn * 4 + wc] = ss;
            }
        }
    }
};
}
#define LAS __attribute__((address_space(3)))
typedef unsigned short bf16;
typedef float f32x4 __attribute__((ext_vector_type(4)));
typedef float f32x16 __attribute__((ext_vector_type(16)));
typedef short bf16x8 __attribute__((ext_vector_type(8)));
typedef unsigned u32x4 __attribute__((ext_vector_type(4)));
typedef unsigned u32x2 __attribute__((ext_vector_type(2)));
constexpr int NB = 4, SEQ = 4096, T = NB * SEQ, DM = 1024, FF = 2816, DEPTH = 4;
constexpr int SSD_IN = 6176, SSD_IN_PAD = 6400, NCHUNK = 32;
constexpr float RMS_EPS = 1e-6f, LOG2E = 1.4426950408889634f;
constexpr float SB_C2 = 0.125f * LOG2E;
constexpr size_t MiB = 1u << 20;
constexpr size_t WS_RSP = 0;
constexpr size_t WS_DT = 1 * MiB;
constexpr size_t WS_ACUM = 3 * MiB;
constexpr size_t WS_ALAST = 5 * MiB;
constexpr size_t WS_BAR = 5 * MiB + 256 * 1024;
constexpr size_t WS_XB = 5 * MiB + 512 * 1024;
constexpr size_t WS_W = WS_XB + 32 * MiB;
constexpr size_t W_GU1 = WS_W, W_D1 = W_GU1 + 11 * MiB, W_GU2 = W_D1 + 5 * MiB + 512 * 1024, W_D2 = W_GU2 + 11 * MiB, W_IN = W_D2 + 5 * MiB + 512 * 1024, W_OUT = W_IN + 12 * MiB + 512 * 1024;
constexpr size_t WS_AR = W_OUT + 4 * MiB;
constexpr size_t WS_END = WS_AR + 320 * MiB;
static_assert(WS_AR == 87 * MiB, "ws map");
constexpr int LDS_BYTES = 147456;
#ifndef MAXSTEP
#define MAXSTEP (8 * DEPTH)
#endif

struct Args { const float* in[22]; float* out; unsigned char* ws; };
typedef const Args __attribute__((address_space(4)))* ArgsP;
__device__ __forceinline__ ArgsP get_args() { ArgsP p = (ArgsP)__builtin_amdgcn_kernarg_segment_ptr(); asm volatile("" : "+s"(p)); return p; }

__device__ __forceinline__ unsigned cvt_pk(float lo, float hi) { return pg8::cvt_pk_bf16(lo, hi); }
__device__ __forceinline__ float bf_lo(unsigned u) { return __uint_as_float(u << 16); }
__device__ __forceinline__ float bf_hi(unsigned u) { return __uint_as_float(u & 0xffff0000u); }
__device__ __forceinline__ float bf_us(unsigned short u) { return __uint_as_float(((unsigned)u) << 16); }
__device__ __forceinline__ float silu_f(float x) { return x * __builtin_amdgcn_rcpf(1.0f + __builtin_amdgcn_exp2f(-x * LOG2E)); }
__device__ __forceinline__ float wave_sum(float v) {
#pragma unroll
    for (int o = 1; o < 64; o <<= 1) v += __shfl_xor(v, o);
    return v;
}
#define LDS_WAIT() asm volatile("s_waitcnt lgkmcnt(0)" ::: "memory")

struct TrDesc { const float* W; bf16* WT; const float* gain; int K, N, mode, item; };
struct TrRegs { f32x4 v[8]; float g[8]; };
__device__ __forceinline__ void tr_load(const TrDesc& d, TrRegs& R, int lane) {
    const int nblk = d.N / 32, kb = d.item / nblk, nb = d.item % nblk, k0 = 64 * kb, n0 = 32 * nb;
    const float* p = d.W + (size_t)(k0 + 2 * (lane >> 3)) * d.N + n0 + 4 * (lane & 7);
#pragma unroll
    for (int i = 0; i < 4; ++i) { R.v[2 * i] = *(const f32x4*)(p + (size_t)(16 * i) * d.N); R.v[2 * i + 1] = *(const f32x4*)(p + (size_t)(16 * i + 1) * d.N);
        R.g[2 * i] = d.gain ? d.gain[k0 + 2 * (lane >> 3) + 16 * i] : 1.0f; R.g[2 * i + 1] = d.gain ? d.gain[k0 + 2 * (lane >> 3) + 16 * i + 1] : 1.0f; }
}
__device__ __forceinline__ void tr_finish(const TrDesc& d, const TrRegs& R, LAS float* scrf, int lane) {
    LAS unsigned* scr = (LAS unsigned*)scrf;
    const int nblk = d.N / 32, kb = d.item / nblk, nb = d.item % nblk, k0 = 64 * kb, n0 = 32 * nb;
#pragma unroll
    for (int i = 0; i < 4; ++i) { const f32x4 a = R.v[2 * i] * R.g[2 * i], b = R.v[2 * i + 1] * R.g[2 * i + 1]; LAS unsigned* q = scr + (4 * (lane & 7)) * 36 + (lane >> 3) + 8 * i;
        q[0] = cvt_pk(a[0], b[0]); q[36] = cvt_pk(a[1], b[1]); q[72] = cvt_pk(a[2], b[2]); q[108] = cvt_pk(a[3], b[3]); }
    LDS_WAIT(); asm volatile("" ::: "memory");
    const int c = lane & 7;
#pragma unroll
    for (int j = 0; j < 4; ++j) {
        const int n = (lane >> 3) + 8 * j; const u32x4 o = *(const LAS u32x4*)(scr + n * 36 + 4 * c);
        int nn = n0 + n, row = nn;
        if (d.mode == 1) { const int up = nn >= FF; if (up) nn -= FF; row = 256 * (nn >> 7) + 128 * up + (nn & 127); }
        *(u32x4*)(d.WT + (size_t)row * d.K + k0 + 8 * c) = o;
    }
    LDS_WAIT(); asm volatile("" ::: "memory");
}

__device__ __forceinline__ void convert_layer(ArgsP ap, int layer, LAS unsigned char* lds, int segmask, int worker, int nworkers) {
    const int tid_ = tid_l(); const int lane = tid_ & 63, wave = __builtin_amdgcn_readfirstlane(tid_ >> 6);
    LAS float* scr = (LAS float*)(lds + wave * 16384);
    const int kind = layer % 3, j = layer / 3;
    unsigned char* ws = ap->ws;
    const int n_in = (kind == 1) ? SSD_IN : 3 * DM, k_out = (kind == 1) ? 2 * DM : DM;
    const float* w_in = (kind == 0) ? ap->in[8] + (size_t)j * DM * 3 * DM : (kind == 1) ? ap->in[10] + (size_t)j * DM * SSD_IN : ap->in[18] + (size_t)j * DM * 3 * DM;
    const float* w_out = (kind == 0) ? ap->in[9] + (size_t)j * DM * DM : (kind == 1) ? ap->in[17] + (size_t)j * 2 * DM * DM : ap->in[20] + (size_t)j * DM * DM;
    const int I_GU1 = (segmask & 1) ? (DM / 64) * (2 * FF / 32) : 0, I_GU2 = (segmask & 2) ? (DM / 64) * (2 * FF / 32) : 0, I_D1 = (segmask & 4) ? (FF / 64) * (DM / 32) : 0, I_D2 = (segmask & 8) ? (FF / 64) * (DM / 32) : 0;
    const int I_IN = (segmask & 16) ? (DM / 64) * (n_in / 32) : 0, I_OUT = (segmask & 32) ? (k_out / 64) * (DM / 32) : 0;
    const int total = I_GU1 + I_GU2 + I_D1 + I_D2 + I_IN + I_OUT;
    const int gw = worker * 8 + wave, NGW = nworkers * 8;
#define TR_DECODE(D, IT) do { int r_ = (IT); \
        if (r_ < I_GU1) { D = TrDesc{ap->in[2] + (size_t)layer * DM * 2 * FF, (bf16*)(ws + W_GU1), ap->in[1] + layer * DM, DM, 2 * FF, 1, r_}; break; } r_ -= I_GU1; \
        if (r_ < I_GU2) { D = TrDesc{ap->in[6] + (size_t)layer * DM * 2 * FF, (bf16*)(ws + W_GU2), ap->in[5] + layer * DM, DM, 2 * FF, 1, r_}; break; } r_ -= I_GU2; \
        if (r_ < I_D1) { D = TrDesc{ap->in[3] + (size_t)layer * FF * DM, (bf16*)(ws + W_D1), nullptr, FF, DM, 0, r_}; break; } r_ -= I_D1; \
        if (r_ < I_D2) { D = TrDesc{ap->in[7] + (size_t)layer * FF * DM, (bf16*)(ws + W_D2), nullptr, FF, DM, 0, r_}; break; } r_ -= I_D2; \
        if (r_ < I_IN) { D = TrDesc{w_in, (bf16*)(ws + W_IN), ap->in[4] + layer * DM, DM, n_in, 0, r_}; break; } r_ -= I_IN; \
        D = TrDesc{w_out, (bf16*)(ws + W_OUT), nullptr, k_out, DM, 0, r_}; } while (0)
    if (gw < total) {
        TrDesc cur; TrRegs rc; TR_DECODE(cur, gw); tr_load(cur, rc, lane);
        for (int it = gw; it < total; it += NGW) {
            TrDesc nxt = cur; TrRegs rn = rc; const bool has = (it + NGW < total);
            if (has) { TR_DECODE(nxt, it + NGW); tr_load(nxt, rn, lane); }
            tr_finish(cur, rc, scr, lane);
            cur = nxt; rc = rn;
        }
    }
#undef TR_DECODE
}

__device__ __forceinline__ void init_rows(ArgsP ap) {
    const int tid_ = tid_l(); const int lane = tid_ & 63, wave = tid_ >> 6;
    const int gw = blockIdx.x * 8 + wave, NGW = gridDim.x * 8;
    bf16* xb = (bf16*)(ap->ws + WS_XB); float* rsp = (float*)(ap->ws + WS_RSP);
    for (int row = gw; row < T; row += NGW) {
        const f32x4* xr = (const f32x4*)(ap->in[0] + (size_t)row * DM) + lane; u32x2* xbr = (u32x2*)(xb + (size_t)row * DM) + lane; float s = 0.f;
#pragma unroll
        for (int jj = 0; jj < 4; ++jj) { const f32x4 v = xr[64 * jj]; u32x2 w; w.x = cvt_pk(v[0], v[1]); w.y = cvt_pk(v[2], v[3]); xbr[64 * jj] = w; s += (v[0] * v[0] + v[1] * v[1]) + (v[2] * v[2] + v[3] * v[3]); }
        s = wave_sum(s);
        if (lane < 4) { f32x4 o = {0.f, 0.f, 0.f, 0.f}; if (lane == 0) o[0] = s; *(f32x4*)(rsp + (size_t)row * 16 + 4 * lane) = o; }
    }
}
__device__ __forceinline__ void final_norm(ArgsP ap) {
    const int tid_ = tid_l(); const int lane = tid_ & 63, wave = tid_ >> 6;
    const int gw = blockIdx.x * 8 + wave, NGW = gridDim.x * 8;
    const float* rsp = (const float*)(ap->ws + WS_RSP); const float* g = ap->in[21]; const bf16* xb = (const bf16*)(ap->ws + WS_XB);
    for (int row = gw; row < T; row += NGW) {
        float s = (lane < 16) ? rsp[(size_t)row * 16 + lane] : 0.f; s = wave_sum(s);
        const float rs = rsqrtf(s * (1.0f / DM) + RMS_EPS);
        f32x4* orow = (f32x4*)(ap->out + (size_t)row * DM) + lane; const f32x4* gr = (const f32x4*)g + lane; const u32x2* xr = (const u32x2*)(xb + (size_t)row * DM) + lane;
#pragma unroll
        for (int jj = 0; jj < 4; ++jj) { const u32x2 xv = xr[64 * jj]; const f32x4 gg = gr[64 * jj]; f32x4 v = {bf_lo(xv.x), bf_hi(xv.x), bf_lo(xv.y), bf_hi(xv.y)}; v = v * rs * gg; orow[64 * jj] = v; }
    }
}

__device__ __forceinline__ void shortconv_phase(const bf16* bg, const bf16* cgp, const bf16* hg, const float* cw, bf16* out) {
    const int nthr = gridDim.x * 512;
    for (int idx = blockIdx.x * 512 + tid_l(); idx < (T / 4) * 128; idx += nthr) {
        const int c8 = idx & 127, row0 = (idx >> 7) * 4, tpos0 = row0 & (SEQ - 1);
        f32x4 w0[3], w1[3];
#pragma unroll
        for (int k = 0; k < 3; ++k) { w0[k] = *(const f32x4*)(cw + k * DM + 8 * c8); w1[k] = *(const f32x4*)(cw + k * DM + 8 * c8 + 4); }
        f32x4 pa[6], pb[6];
        u32x4 bv[4];
#pragma unroll
        for (int t = 0; t < 6; ++t) {
            pa[t] = (f32x4){0.f, 0.f, 0.f, 0.f}; pb[t] = pa[t];
            if (tpos0 - 2 + t >= 0) {
                const size_t off = (size_t)(row0 - 2 + t) * DM + 8 * c8;
                const u32x4 cv = *(const u32x4*)(cgp + off), hv = *(const u32x4*)(hg + off);
                pa[t] = (f32x4){bf_lo(cv[0]) * bf_lo(hv[0]), bf_hi(cv[0]) * bf_hi(hv[0]), bf_lo(cv[1]) * bf_lo(hv[1]), bf_hi(cv[1]) * bf_hi(hv[1])};
                pb[t] = (f32x4){bf_lo(cv[2]) * bf_lo(hv[2]), bf_hi(cv[2]) * bf_hi(hv[2]), bf_lo(cv[3]) * bf_lo(hv[3]), bf_hi(cv[3]) * bf_hi(hv[3])};
            }
        }
#pragma unroll
        for (int t = 0; t < 4; ++t) bv[t] = *(const u32x4*)(bg + (size_t)(row0 + t) * DM + 8 * c8);
#pragma unroll
        for (int t = 0; t < 4; ++t) {
            const f32x4 ua = w0[0] * pa[t] + w0[1] * pa[t + 1] + w0[2] * pa[t + 2], ub = w1[0] * pb[t] + w1[1] * pb[t + 1] + w1[2] * pb[t + 2];
            u32x4 o; o[0] = cvt_pk(bf_lo(bv[t][0]) * ua[0], bf_hi(bv[t][0]) * ua[1]); o[1] = cvt_pk(bf_lo(bv[t][1]) * ua[2], bf_hi(bv[t][1]) * ua[3]);
            o[2] = cvt_pk(bf_lo(bv[t][2]) * ub[0], bf_hi(bv[t][2]) * ub[1]); o[3] = cvt_pk(bf_lo(bv[t][3]) * ub[2], bf_hi(bv[t][3]) * ub[3]);
            *(u32x4*)(out + (size_t)(row0 + t) * DM + 8 * c8) = o;
        }
    }
}
namespace sba {
constexpr int KS_OFF = 0, VT_OFF = 8192, VT_PITCH = 192, BUF_BYTES = VT_OFF + 64 * VT_PITCH, FLAG_OFF = 4 * BUF_BYTES;
typedef short v4i16_tr __attribute__((ext_vector_type(4)));
__device__ __forceinline__ void unit(LAS unsigned char* lds_all, const bf16* Q, const bf16* K, const bf16* V, bf16* O, int b, int hp, int qb) {
    const int tid = tid_l(), lane = tid & 63, r32 = lane & 31, hi = lane >> 5; const int wid = __builtin_amdgcn_readfirstlane(tid >> 6);
    const int hf = wid >> 2, h = 2 * hp + hf; LAS unsigned char* lds = lds_all + hf * (2 * BUF_BYTES);
    const size_t rowbase = (size_t)b * SEQ; const int q0 = qb * 128, qw0 = q0 + (wid & 3) * 32;
    bf16x8 qr[4];
    { const bf16* qp = Q + (rowbase + qw0 + r32) * DM + h * 64 + hi * 8;
#pragma unroll
      for (int d0 = 0; d0 < 4; ++d0) qr[d0] = *(const bf16x8*)(qp + d0 * 16); }
    f32x16 o0, o1;
#pragma unroll
    for (int r = 0; r < 16; ++r) { o0[r] = 0.f; o1[r] = 0.f; }
    float carry = 1.0f; bool done = false;
    const int NT = (q0 + 128) / 64;
    const int skey = (tid & 255) >> 2, sc = 2 * (tid & 3);
    const bf16* kg = K + (rowbase + skey) * DM + h * 64 + sc * 8; const bf16* vg = V + (rowbase + skey) * DM + h * 64 + sc * 8;
#define SBA_LOAD(TT) do { const size_t o_ = (size_t)(TT) * 64 * DM; kreg = *(const u32x4*)(kg + o_); kreg2 = *(const u32x4*)(kg + o_ + 8); vreg = *(const u32x4*)(vg + o_); vreg2 = *(const u32x4*)(vg + o_ + 8); } while (0)
    u32x4 kreg, kreg2, vreg, vreg2; SBA_LOAD(NT - 1);
#define SBA_STAGE(BUF) do { LAS unsigned char* bb_ = lds + (BUF) * BUF_BYTES; *(LAS u32x4*)(bb_ + KS_OFF + sc * 1024 + skey * 16) = kreg; *(LAS u32x4*)(bb_ + KS_OFF + (sc + 1) * 1024 + skey * 16) = kreg2; \
        *(LAS u32x4*)(bb_ + VT_OFF + skey * VT_PITCH + sc * 16) = vreg; *(LAS u32x4*)(bb_ + VT_OFF + skey * VT_PITCH + (sc + 1) * 16) = vreg2; } while (0)
    __syncthreads();
    SBA_STAGE(0);
    if (NT > 1) SBA_LOAD(NT - 2);
    __syncthreads();
    for (int t = NT - 1; t >= 0; --t) {
        const int cur = (NT - 1 - t) & 1;
        if (t > 0) SBA_STAGE(cur ^ 1);
        if (t > 1) SBA_LOAD(t - 2);
        if (!done && 64 * t <= qw0) {
            const LAS unsigned char* bb = lds + cur * BUF_BYTES;
            f32x16 p0, p1;
#pragma unroll
            for (int r = 0; r < 16; ++r) { p0[r] = 0.f; p1[r] = 0.f; }
            const LAS unsigned char* kb = bb + KS_OFF + hi * 1024 + r32 * 16;
#pragma unroll
            for (int d0 = 0; d0 < 4; ++d0) {
                const bf16x8 a0 = *(const LAS bf16x8*)(kb + d0 * 2048), a1 = *(const LAS bf16x8*)(kb + d0 * 2048 + 512);
                p0 = __builtin_amdgcn_mfma_f32_32x32x16_bf16(a0, qr[d0], p0, 0, 0, 0);
                p1 = __builtin_amdgcn_mfma_f32_32x32x16_bf16(a1, qr[d0], p1, 0, 0, 0);
            }
            const bool need_mask = (64 * t + 64 > qw0);
            const int qrel = qw0 + r32 - 64 * t;
            unsigned pw[16];
#pragma unroll
            for (int i = 7; i >= 0; --i) {
                const int half = i >> 2, rg = i & 3;
                f32x4 zv;
#pragma unroll
                for (int e = 0; e < 4; ++e) zv[e] = half ? p1[4 * rg + e] : p0[4 * rg + e];
                f32x4 ev;
#pragma unroll
                for (int e = 0; e < 4; ++e) ev[e] = __builtin_amdgcn_exp2f(-zv[e]);
                ev = ev + 1.0f;
                f32x4 bt;
#pragma unroll
                for (int e = 0; e < 4; ++e) bt[e] = __builtin_amdgcn_rcpf(ev[e]);
                if (need_mask) {
#pragma unroll
                    for (int e = 0; e < 4; ++e) { const int keyrel = 32 * half + 8 * rg + 4 * hi + e; if (keyrel >= qrel) bt[e] = 0.f; }
                }
                const f32x4 kp = 1.0f - bt;
                const float t3 = kp[3], t2 = t3 * kp[2], t1 = t2 * kp[1], tot = t1 * kp[0];
                const auto rr = __builtin_amdgcn_permlane32_swap(__float_as_uint(tot), __float_as_uint(tot), false, false);
                const float ta = __uint_as_float(rr[0]), tb = __uint_as_float(rr[1]);
                const float E = hi ? carry : carry * tb;
                carry = carry * (ta * tb);
                const f32x4 tv = {t1, t2, t3, 1.0f};
                const f32x4 pv = (bt * tv) * E;
                pw[2 * i] = cvt_pk(pv[0], pv[1]); pw[2 * i + 1] = cvt_pk(pv[2], pv[3]);
            }
            const LAS unsigned char* vb = bb + VT_OFF + (4 * hi + ((lane & 15) >> 2)) * VT_PITCH + (16 * ((lane >> 4) & 1) + 4 * (lane & 3)) * 2;
#pragma unroll
            for (int ks = 0; ks < 4; ++ks) {
                u32x4 bw; bw.x = pw[4 * ks]; bw.y = pw[4 * ks + 1]; bw.z = pw[4 * ks + 2]; bw.w = pw[4 * ks + 3];
                const bf16x8 bfrag = __builtin_bit_cast(bf16x8, bw);
#pragma unroll
                for (int dh = 0; dh < 2; ++dh) {
                    const v4i16_tr lo = __builtin_amdgcn_ds_read_tr16_b64_v4i16((LAS v4i16_tr*)(vb + (16 * ks) * VT_PITCH + dh * 64));
                    const v4i16_tr h2 = __builtin_amdgcn_ds_read_tr16_b64_v4i16((LAS v4i16_tr*)(vb + (16 * ks + 8) * VT_PITCH + dh * 64));
                    const bf16x8 afrag = (bf16x8){lo[0], lo[1], lo[2], lo[3], h2[0], h2[1], h2[2], h2[3]};
                    if (dh == 0) o0 = __builtin_amdgcn_mfma_f32_32x32x16_bf16(afrag, bfrag, o0, 0, 0, 0);
                    else o1 = __builtin_amdgcn_mfma_f32_32x32x16_bf16(afrag, bfrag, o1, 0, 0, 0);
                }
            }
            done = __all(carry == 0.0f);
        }
        if (lane == 0) *(LAS int*)(lds_all + FLAG_OFF + (cur * 8 + wid) * 4) = done ? 1 : 0;
        __syncthreads();
        { const u32x4 f0 = *(LAS u32x4*)(lds_all + FLAG_OFF + cur * 32), f1 = *(LAS u32x4*)(lds_all + FLAG_OFF + cur * 32 + 16);
          const unsigned alld = f0[0] & f0[1] & f0[2] & f0[3] & f1[0] & f1[1] & f1[2] & f1[3];
          if (__builtin_amdgcn_readfirstlane(alld) != 0u) break; }
    }
#undef SBA_STAGE
#undef SBA_LOAD
    bf16* op = O + (rowbase + qw0 + r32) * DM + h * 64 + 4 * hi;
#pragma unroll
    for (int rg = 0; rg < 4; ++rg) {
        u32x2 w0; w0.x = cvt_pk(o0[4 * rg], o0[4 * rg + 1]); w0.y = cvt_pk(o0[4 * rg + 2], o0[4 * rg + 3]); *(u32x2*)(op + 8 * rg) = w0;
        u32x2 w1; w1.x = cvt_pk(o1[4 * rg], o1[4 * rg + 1]); w1.y = cvt_pk(o1[4 * rg + 2], o1[4 * rg + 3]); *(u32x2*)(op + 32 + 8 * rg) = w1;
    }
}
__device__ __forceinline__ void phase(LAS unsigned char* lds, const bf16* Q, const bf16* K, const bf16* V, bf16* O) {
    for (int i = blockIdx.x; i < 1024; i += gridDim.x) {
        const int v = i & 255, rnd = i >> 8, bp = v >> 3, s = v & 7;
        const int qb = (rnd == 0) ? s : (rnd == 1) ? 15 - s : (rnd == 2) ? 16 + s : 31 - s;
        unit(lds, Q, K, V, O, bp >> 3, bp & 7, qb);
    }
}
}
namespace ssd {
constexpr int XN_OFF = 0, XN_PITCH = 528, BN_OFF = 128 * XN_PITCH, BN_PITCH = 272, CN_OFF = BN_OFF + 128 * BN_PITCH, DTV_OFF = CN_OFF + 128 * BN_PITCH, ACU_OFF = DTV_OFF + 2048, WTOT_OFF = ACU_OFF + 2048, S1_LDS = WTOT_OFF + 64;
static_assert(S1_LDS <= LDS_BYTES, "S1 LDS");
struct Bufs { const bf16* z; const bf16* xs_raw; const bf16* bc_raw; bf16* ypart; bf16* states; bf16* hprev; bf16* yn; bf16* cc; const float* dt_raw; float* acum; float* alast;
              const float* conv_w; const float* conv_b; const float* dt_bias; const float* a_log; const float* dsk; const float* ng; };

__device__ __forceinline__ u32x4 conv8(const bf16* src, size_t row, int tpos, int col, const float* cw, const float* cb, int cch) {
    float acc[8];
    { const f32x4 b0 = *(const f32x4*)(cb + cch), b1 = *(const f32x4*)(cb + cch + 4);
#pragma unroll
      for (int e = 0; e < 4; ++e) { acc[e] = b0[e]; acc[4 + e] = b1[e]; } }
#pragma unroll
    for (int k = 0; k < 4; ++k) {
        if (tpos - 3 + k >= 0) {
            const u32x4 raw = *(const u32x4*)(src + (row - 3 + k) * 2048 + col);
            const f32x4 w0 = *(const f32x4*)(cw + k * 4096 + cch), w1 = *(const f32x4*)(cw + k * 4096 + cch + 4);
            acc[0] += w0[0] * bf_lo(raw[0]); acc[1] += w0[1] * bf_hi(raw[0]); acc[2] += w0[2] * bf_lo(raw[1]); acc[3] += w0[3] * bf_hi(raw[1]);
            acc[4] += w1[0] * bf_lo(raw[2]); acc[5] += w1[1] * bf_hi(raw[2]); acc[6] += w1[2] * bf_lo(raw[3]); acc[7] += w1[3] * bf_hi(raw[3]);
        }
    }
    u32x4 o;
#pragma unroll
    for (int q = 0; q < 4; ++q) o[q] = cvt_pk(silu_f(acc[2 * q]), silu_f(acc[2 * q + 1]));
    return o;
}
typedef short v4i16_tr __attribute__((ext_vector_type(4)));
__device__ __forceinline__ bf16x8 tr8(const LAS unsigned char* p, int step_bytes) {
    const v4i16_tr lo = __builtin_amdgcn_ds_read_tr16_b64_v4i16((LAS v4i16_tr*)p), h2 = __builtin_amdgcn_ds_read_tr16_b64_v4i16((LAS v4i16_tr*)(p + step_bytes));
    return (bf16x8){lo[0], lo[1], lo[2], lo[3], h2[0], h2[1], h2[2], h2[3]};
}
__device__ __forceinline__ bf16x8 gather8(const LAS unsigned char* p, int pitch) {
    u32x4 w;
#pragma unroll
    for (int q = 0; q < 4; ++q) { const unsigned lo = *(const LAS unsigned short*)(p + (2 * q) * pitch), hh = *(const LAS unsigned short*)(p + (2 * q + 1) * pitch); w[q] = lo | (hh << 16); }
    return __builtin_bit_cast(bf16x8, w);
}

template <int NT> __device__ __forceinline__ void conv_load(u32x4 (&raw)[NT + 3], const bf16* src, size_t row0, int tpos0, int l0, int col) {
#pragma unroll
    for (int t = 0; t < NT + 3; ++t) { const int l = l0 - 3 + t; raw[t] = (u32x4){0u, 0u, 0u, 0u}; if (tpos0 + l >= 0) raw[t] = *(const u32x4*)(src + (row0 + l) * 2048 + col); }
}
template <int NT, class F> __device__ __forceinline__ void conv_compute(const u32x4 (&raw)[NT + 3], const float* cw, const float* cb, int cch, F out) {
    float w[4][8], bias[8];
#pragma unroll
    for (int k = 0; k < 4; ++k) { const f32x4 w0 = *(const f32x4*)(cw + k * 4096 + cch), w1 = *(const f32x4*)(cw + k * 4096 + cch + 4);
#pragma unroll
        for (int e = 0; e < 4; ++e) { w[k][e] = w0[e]; w[k][4 + e] = w1[e]; } }
    { const f32x4 b0 = *(const f32x4*)(cb + cch), b1 = *(const f32x4*)(cb + cch + 4);
#pragma unroll
      for (int e = 0; e < 4; ++e) { bias[e] = b0[e]; bias[4 + e] = b1[e]; } }
#pragma unroll
    for (int t = 0; t < NT; ++t) {
        float acc[8];
#pragma unroll
        for (int e = 0; e < 8; ++e) acc[e] = bias[e];
#pragma unroll
        for (int k = 0; k < 4; ++k) {
#pragma unroll
            for (int q = 0; q < 4; ++q) { acc[2 * q] += w[k][2 * q] * bf_lo(raw[t + k][q]); acc[2 * q + 1] += w[k][2 * q + 1] * bf_hi(raw[t + k][q]); }
        }
        u32x4 o;
#pragma unroll
        for (int q = 0; q < 4; ++q) o[q] = cvt_pk(silu_f(acc[2 * q]), silu_f(acc[2 * q + 1]));
        out(t, o);
    }
}

__device__ __forceinline__ void s1_item(LAS unsigned char* lds, const Bufs& B, int item) {
    const int tid = tid_l(), lane = tid & 63, r32 = lane & 31, hi = lane >> 5; const int wid = __builtin_amdgcn_readfirstlane(tid >> 6);
    const int g = item & 7, c = (item >> 3) & 31, b = item >> 8;
    const size_t row0 = (size_t)b * SEQ + c * 128; const int tpos0 = c * 128;
    const float dt_in = B.dt_raw[(row0 + (tid & 127)) * 32 + 4 * g + (tid >> 7)] + B.dt_bias[4 * g + (tid >> 7)], alog_in = B.a_log[4 * g + (tid >> 7)];
    __syncthreads();
    { const int c8x = tid & 31, l0x = 8 * (tid >> 5), c8 = tid & 15, l0 = 4 * (tid >> 4);
      u32x4 rx[11], rb[7], rc[7];
      conv_load<8>(rx, B.xs_raw, row0, tpos0, l0x, 256 * g + 8 * c8x);
      conv_load<4>(rb, B.bc_raw, row0, tpos0, l0, 128 * g + 8 * c8);
      conv_load<4>(rc, B.bc_raw, row0, tpos0, l0, 1024 + 128 * g + 8 * c8);
      conv_compute<8>(rx, B.conv_w, B.conv_b, 256 * g + 8 * c8x, [&](int t, u32x4 v) { *(LAS u32x4*)(lds + XN_OFF + (l0x + t) * XN_PITCH + c8x * 16) = v; });
      conv_compute<4>(rb, B.conv_w, B.conv_b, 2048 + 128 * g + 8 * c8, [&](int t, u32x4 v) { *(LAS u32x4*)(lds + BN_OFF + (l0 + t) * BN_PITCH + c8 * 16) = v; });
      conv_compute<4>(rc, B.conv_w, B.conv_b, 3072 + 128 * g + 8 * c8, [&](int t, u32x4 v) { *(LAS u32x4*)(lds + CN_OFF + (l0 + t) * BN_PITCH + c8 * 16) = v;
          *(u32x4*)(B.cc + (row0 + l0 + t) * 1024 + 128 * g + 8 * c8) = v; }); }
    float dtv, scan;
    { const int r = tid >> 7, l = tid & 127, hh = 4 * g + r;
      const float x = dt_in;
      dtv = (x > 20.f) ? x : log1pf(__expf(x));
      const float av = -__expf(alog_in);
      scan = dtv * av;
#pragma unroll
      for (int o = 1; o < 64; o <<= 1) { const float v = __shfl_up(scan, o); if (lane >= o) scan += v; }
      if (lane == 63) *(LAS float*)(lds + WTOT_OFF + wid * 4) = scan; }
    __syncthreads();
    { const int r = tid >> 7, l = tid & 127, hh = 4 * g + r;
      if (l >= 64) scan += *(LAS float*)(lds + WTOT_OFF + (wid - 1) * 4);
      *(LAS float*)(lds + ACU_OFF + (r * 128 + l) * 4) = scan; *(LAS float*)(lds + DTV_OFF + (r * 128 + l) * 4) = dtv;
      B.acum[(row0 + l) * 32 + hh] = scan;
      if (l == 127) B.alast[(b * NCHUNK + c) * 32 + hh] = scan; }
    __syncthreads();
    {
        const int r = wid >> 1, pb = wid & 1, head = 4 * g + r;
        const float al = *(const LAS float*)(lds + ACU_OFF + (r * 128 + 127) * 4);
        bf16x8 xa[8];
#pragma unroll
        for (int ks = 0; ks < 8; ++ks) {
            const int s0 = 16 * ks + 8 * hi;
            const f32x4 a0 = *(const LAS f32x4*)(lds + ACU_OFF + (r * 128 + s0) * 4), a1 = *(const LAS f32x4*)(lds + ACU_OFF + (r * 128 + s0 + 4) * 4);
            const f32x4 d0 = *(const LAS f32x4*)(lds + DTV_OFF + (r * 128 + s0) * 4), d1 = *(const LAS f32x4*)(lds + DTV_OFF + (r * 128 + s0 + 4) * 4);
            const bf16x8 xr8 = tr8(lds + XN_OFF + (s0 + ((lane & 15) >> 2)) * XN_PITCH + (64 * r + 32 * pb + 16 * ((lane >> 4) & 1) + 4 * (lane & 3)) * 2, 4 * XN_PITCH);
            float v[8];
#pragma unroll
            for (int j = 0; j < 8; ++j) { const float te = __expf(al - (j < 4 ? a0[j & 3] : a1[j & 3])) * (j < 4 ? d0[j & 3] : d1[j & 3]); v[j] = bf_us((unsigned short)xr8[j]) * te; }
            u32x4 w; w.x = cvt_pk(v[0], v[1]); w.y = cvt_pk(v[2], v[3]); w.z = cvt_pk(v[4], v[5]); w.w = cvt_pk(v[6], v[7]);
            xa[ks] = __builtin_bit_cast(bf16x8, w);
        }
        bf16* sp = B.states + ((((size_t)b * NCHUNK + c) * 32 + head) * 64 + 32 * pb + r32) * 128 + 4 * hi;
#pragma unroll 1
        for (int nb = 0; nb < 4; ++nb) {
            f32x16 st;
#pragma unroll
            for (int q = 0; q < 16; ++q) st[q] = 0.f;
#pragma unroll
            for (int ks = 0; ks < 8; ++ks) {
                const bf16x8 af = tr8(lds + BN_OFF + (16 * ks + 8 * hi + ((lane & 15) >> 2)) * BN_PITCH + (32 * nb + 16 * ((lane >> 4) & 1) + 4 * (lane & 3)) * 2, 4 * BN_PITCH);
                st = __builtin_amdgcn_mfma_f32_32x32x16_bf16(af, xa[ks], st, 0, 0, 0);
            }
#pragma unroll
            for (int rg = 0; rg < 4; ++rg) { u32x2 w; w.x = cvt_pk(st[4 * rg], st[4 * rg + 1]); w.y = cvt_pk(st[4 * rg + 2], st[4 * rg + 3]); *(u32x2*)(sp + 32 * nb + 8 * rg) = w; }
        }
    }
    const int lb = wid & 3, hp = wid >> 2, l = 32 * lb + r32;
    f32x16 yv[2][2];
    {
        bf16x8 cf[8];
#pragma unroll
        for (int k = 0; k < 8; ++k) cf[k] = *(const LAS bf16x8*)(lds + CN_OFF + l * BN_PITCH + (16 * k + 8 * hi) * 2);
        f32x16 cb[4];
#pragma unroll
        for (int sb = 0; sb < 4; ++sb) {
#pragma unroll
            for (int r = 0; r < 16; ++r) cb[sb][r] = 0.f;
            if (sb <= lb) {
#pragma unroll
                for (int k = 0; k < 8; ++k) { const bf16x8 af = *(const LAS bf16x8*)(lds + BN_OFF + (32 * sb + r32) * BN_PITCH + (16 * k + 8 * hi) * 2);
                    cb[sb] = __builtin_amdgcn_mfma_f32_32x32x16_bf16(af, cf[k], cb[sb], 0, 0, 0); }
            }
        }
#pragma unroll
        for (int hh = 0; hh < 2; ++hh) {
            const int r = 2 * hp + hh, head = 4 * g + r;
            const float acl = *(const LAS float*)(lds + ACU_OFF + (r * 128 + l) * 4);
            const float dsk = B.dsk[head];
            f32x16 y0, y1;
#pragma unroll
            for (int q = 0; q < 16; ++q) { y0[q] = 0.f; y1[q] = 0.f; }
#pragma unroll
            for (int sb = 0; sb < 4; ++sb) {
                if (sb <= lb) {
                    unsigned pwv[8];
#pragma unroll
                    for (int rg = 0; rg < 4; ++rg) {
                        const int sl = 32 * sb + 8 * rg + 4 * hi;
                        const f32x4 as4 = *(const LAS f32x4*)(lds + ACU_OFF + (r * 128 + sl) * 4), dt4 = *(const LAS f32x4*)(lds + DTV_OFF + (r * 128 + sl) * 4);
                        float w[4];
#pragma unroll
                        for (int e = 0; e < 4; ++e) { float v = cb[sb][4 * rg + e] * __expf(acl - as4[e]) * dt4[e]; if (sl + e > l) v = 0.f; if (sl + e == l) v += dsk; w[e] = v; }
                        pwv[2 * rg] = cvt_pk(w[0], w[1]); pwv[2 * rg + 1] = cvt_pk(w[2], w[3]);
                    }
#pragma unroll
                    for (int ks = 0; ks < 2; ++ks) {
                        u32x4 bw; bw.x = pwv[4 * ks]; bw.y = pwv[4 * ks + 1]; bw.z = pwv[4 * ks + 2]; bw.w = pwv[4 * ks + 3];
                        const bf16x8 bfrag = __builtin_bit_cast(bf16x8, bw);
                        const LAS unsigned char* xq = lds + XN_OFF + (32 * sb + 16 * ks + 4 * hi + ((lane & 15) >> 2)) * XN_PITCH + (64 * r + 16 * ((lane >> 4) & 1) + 4 * (lane & 3)) * 2;
#pragma unroll
                        for (int pb = 0; pb < 2; ++pb) {
                            const bf16x8 afrag = tr8(xq + pb * 64, 8 * XN_PITCH);
                            if (pb == 0) y0 = __builtin_amdgcn_mfma_f32_32x32x16_bf16(afrag, bfrag, y0, 0, 0, 0);
                            else y1 = __builtin_amdgcn_mfma_f32_32x32x16_bf16(afrag, bfrag, y1, 0, 0, 0);
                        }
                    }
                }
            }
            yv[hh][0] = y0; yv[hh][1] = y1;
        }
    }
    __syncthreads();
#pragma unroll
    for (int hh = 0; hh < 2; ++hh)
#pragma unroll
        for (int pb = 0; pb < 2; ++pb) {
            LAS unsigned char* yl = lds + XN_OFF + l * XN_PITCH + (64 * (2 * hp + hh) + 32 * pb + 4 * hi) * 2;
#pragma unroll
            for (int rg = 0; rg < 4; ++rg) { u32x2 w; w.x = cvt_pk(yv[hh][pb][4 * rg], yv[hh][pb][4 * rg + 1]); w.y = cvt_pk(yv[hh][pb][4 * rg + 2], yv[hh][pb][4 * rg + 3]); *(LAS u32x2*)(yl + 16 * rg) = w; }
        }
    __syncthreads();
#pragma unroll 4
    for (int i = 0; i < 8; ++i) { const int idx = tid + 512 * i, ll = idx >> 5, c8 = idx & 31;
        *(u32x4*)(B.ypart + (row0 + ll) * 2048 + 256 * g + 8 * c8) = *(const LAS u32x4*)(lds + XN_OFF + ll * XN_PITCH + c8 * 16); }
}

__device__ __forceinline__ void s2_phase(const Bufs& B) {
    const int nthr = gridDim.x * 512;
    for (int idx = blockIdx.x * 512 + tid_l(); idx < NB * 32 * 64 * 16; idx += nthr) {
        const int n8 = idx & 15, p = (idx >> 4) & 63, head = (idx >> 10) & 31, b = idx >> 15;
        float hacc[8];
#pragma unroll
        for (int e = 0; e < 8; ++e) hacc[e] = 0.f;
        const size_t base = (((size_t)b * NCHUNK) * 32 + head) * 8192 + p * 128 + 8 * n8;
        u32x4 nxt = *(const u32x4*)(B.states + base);
#pragma unroll 4
        for (int c = 0; c < NCHUNK; ++c) {
            const size_t off = base + (size_t)c * 32 * 8192;
            const u32x4 st = nxt;
            if (c + 1 < NCHUNK) nxt = *(const u32x4*)(B.states + off + (size_t)32 * 8192);
            u32x4 o;
#pragma unroll
            for (int q = 0; q < 4; ++q) o[q] = cvt_pk(hacc[2 * q], hacc[2 * q + 1]);
            *(u32x4*)(B.hprev + off) = o;
            const float dec = __expf(B.alast[(b * NCHUNK + c) * 32 + head]);
#pragma unroll
            for (int q = 0; q < 4; ++q) { hacc[2 * q] = hacc[2 * q] * dec + bf_lo(st[q]); hacc[2 * q + 1] = hacc[2 * q + 1] * dec + bf_hi(st[q]); }
        }
    }
}

constexpr int S3_Y = 0, S3_Z = 128 * XN_PITCH, S3_TAB = 2 * 128 * XN_PITCH;
__device__ __forceinline__ void s3_item(LAS unsigned char* lds, const Bufs& B, int item) {
    const int tid = tid_l(), lane = tid & 63, r32 = lane & 31, hi = lane >> 5; const int wid = __builtin_amdgcn_readfirstlane(tid >> 6);
    const int g = item & 7, c = (item >> 3) & 31, b = item >> 8;
    const int lb = wid & 3, hp = wid >> 2, l = 32 * lb + r32;
    const size_t row0 = (size_t)b * SEQ + c * 128, row = row0 + l;
    __syncthreads();
#pragma unroll 4
    for (int i = 0; i < 8; ++i) { const int idx = tid + 512 * i, ll = idx >> 5, c8 = idx & 31; const size_t off = (row0 + ll) * 2048 + 256 * g + 8 * c8;
        *(LAS u32x4*)(lds + S3_Y + ll * XN_PITCH + c8 * 16) = *(const u32x4*)(B.ypart + off);
        *(LAS u32x4*)(lds + S3_Z + ll * XN_PITCH + c8 * 16) = *(const u32x4*)(B.z + off); }
    bf16x8 cf[8];
#pragma unroll
    for (int k = 0; k < 8; ++k) cf[k] = *(const bf16x8*)(B.cc + row * 1024 + 128 * g + 16 * k + 8 * hi);
    const float ac0 = B.acum[row * 32 + 4 * g + 2 * hp], ac1 = B.acum[row * 32 + 4 * g + 2 * hp + 1];
    f32x16 y[2][2];
#pragma unroll
    for (int hh = 0; hh < 2; ++hh) {
        const int head = 4 * g + 2 * hp + hh;
        const bf16* hb = B.hprev + (((size_t)b * NCHUNK + c) * 32 + head) * 8192 + (size_t)r32 * 128 + 8 * hi;
#pragma unroll
        for (int pb = 0; pb < 2; ++pb) {
            f32x16 acc;
#pragma unroll
            for (int q = 0; q < 16; ++q) acc[q] = 0.f;
#pragma unroll
            for (int k = 0; k < 8; ++k) { const bf16x8 af = *(const bf16x8*)(hb + pb * 32 * 128 + 16 * k); acc = __builtin_amdgcn_mfma_f32_32x32x16_bf16(af, cf[k], acc, 0, 0, 0); }
            y[hh][pb] = acc;
        }
    }
    __syncthreads();
    float ss = 0.f;
#pragma unroll
    for (int hh = 0; hh < 2; ++hh) {
        const int r = 2 * hp + hh;
        const float ea = __expf(hh ? ac1 : ac0);
#pragma unroll
        for (int pb = 0; pb < 2; ++pb) {
            const int cl = 64 * r + 32 * pb + 4 * hi;
#pragma unroll
            for (int rg = 0; rg < 4; ++rg) {
                const u32x2 yp = *(const LAS u32x2*)(lds + S3_Y + l * XN_PITCH + (cl + 8 * rg) * 2), zz = *(const LAS u32x2*)(lds + S3_Z + l * XN_PITCH + (cl + 8 * rg) * 2);
                const float v0 = (bf_lo(yp.x) + ea * y[hh][pb][4 * rg]) * silu_f(bf_lo(zz.x)), v1 = (bf_hi(yp.x) + ea * y[hh][pb][4 * rg + 1]) * silu_f(bf_hi(zz.x));
                const float v2 = (bf_lo(yp.y) + ea * y[hh][pb][4 * rg + 2]) * silu_f(bf_lo(zz.y)), v3 = (bf_hi(yp.y) + ea * y[hh][pb][4 * rg + 3]) * silu_f(bf_hi(zz.y));
                y[hh][pb][4 * rg] = v0; y[hh][pb][4 * rg + 1] = v1; y[hh][pb][4 * rg + 2] = v2; y[hh][pb][4 * rg + 3] = v3;
                ss += (v0 * v0 + v1 * v1) + (v2 * v2 + v3 * v3);
            }
        }
    }
    ss += __shfl_xor(ss, 32);
    if (hi == 0) *(LAS float*)(lds + S3_TAB + (wid * 32 + r32) * 4) = ss;
    __syncthreads();
    const float tot = *(const LAS float*)(lds + S3_TAB + (wid * 32 + r32) * 4) + *(const LAS float*)(lds + S3_TAB + ((wid ^ 4) * 32 + r32) * 4);
    const float rs = rsqrtf(tot * (1.0f / 256.0f) + RMS_EPS);
#pragma unroll
    for (int hh = 0; hh < 2; ++hh)
#pragma unroll
        for (int pb = 0; pb < 2; ++pb) {
            const int cl = 64 * (2 * hp + hh) + 32 * pb + 4 * hi;
#pragma unroll
            for (int rg = 0; rg < 4; ++rg) {
                const f32x4 gg = *(const f32x4*)(B.ng + 256 * g + cl + 8 * rg);
                u32x2 w; w.x = cvt_pk(y[hh][pb][4 * rg] * rs * gg[0], y[hh][pb][4 * rg + 1] * rs * gg[1]); w.y = cvt_pk(y[hh][pb][4 * rg + 2] * rs * gg[2], y[hh][pb][4 * rg + 3] * rs * gg[3]);
                *(LAS u32x2*)(lds + S3_Y + l * XN_PITCH + (cl + 8 * rg) * 2) = w;
            }
        }
    __syncthreads();
#pragma unroll 4
    for (int i = 0; i < 8; ++i) { const int idx = tid + 512 * i, ll = idx >> 5, c8 = idx & 31;
        *(u32x4*)(B.yn + (row0 + ll) * 2048 + 256 * g + 8 * c8) = *(const LAS u32x4*)(lds + S3_Y + ll * XN_PITCH + c8 * 16); }
}
constexpr int S3W_PITCH = 144, S3W_TILE = 32 * S3W_PITCH, S3W_BYTES = 2 * S3W_TILE;
__device__ __forceinline__ void s3_wave_item(LAS unsigned char* wl, const Bufs& B, int witem, int lane) {
    const int r32 = lane & 31, hi = lane >> 5;
    const int lb = witem & 3, g = (witem >> 2) & 7, c = (witem >> 5) & 31, b = witem >> 10;
    const size_t row0 = (size_t)b * SEQ + c * 128 + 32 * lb, row = row0 + r32;
    LAS unsigned char* Yt = wl; LAS unsigned char* Zt = wl + S3W_TILE;
    bf16x8 cf[8];
#pragma unroll
    for (int k = 0; k < 8; ++k) cf[k] = *(const bf16x8*)(B.cc + row * 1024 + 128 * g + 16 * k + 8 * hi);
    const f32x4 ac4 = *(const f32x4*)(B.acum + row * 32 + 4 * g);
    unsigned yk[4][2][8]; float ss = 0.f;
    const int srow = lane >> 3, sch = lane & 7;
#pragma unroll
    for (int r = 0; r < 4; ++r) {
        const int head = 4 * g + r;
        const bf16* hb = B.hprev + (((size_t)b * NCHUNK + c) * 32 + head) * 8192 + (size_t)r32 * 128 + 8 * hi;
        u32x4 yl[4], zl[4];
#pragma unroll
        for (int i = 0; i < 4; ++i) { const size_t off = (row0 + srow + 8 * i) * 2048 + 256 * g + 64 * r + 8 * sch; yl[i] = *(const u32x4*)(B.ypart + off); zl[i] = *(const u32x4*)(B.z + off); }
        f32x16 accs[2];
#pragma unroll
        for (int pb = 0; pb < 2; ++pb) {
            f32x16 acc;
#pragma unroll
            for (int q = 0; q < 16; ++q) acc[q] = 0.f;
#pragma unroll
            for (int k = 0; k < 8; ++k) { const bf16x8 af = *(const bf16x8*)(hb + pb * 32 * 128 + 16 * k); acc = __builtin_amdgcn_mfma_f32_32x32x16_bf16(af, cf[k], acc, 0, 0, 0); }
            accs[pb] = acc;
        }
#pragma unroll
        for (int i = 0; i < 4; ++i) { *(LAS u32x4*)(Yt + (srow + 8 * i) * S3W_PITCH + sch * 16) = yl[i]; *(LAS u32x4*)(Zt + (srow + 8 * i) * S3W_PITCH + sch * 16) = zl[i]; }
        asm volatile("" ::: "memory");
        const float ea = __expf(ac4[r]);
#pragma unroll
        for (int pb = 0; pb < 2; ++pb)
#pragma unroll
            for (int rg = 0; rg < 4; ++rg) {
                const int cl = 32 * pb + 8 * rg + 4 * hi;
                const u32x2 yp = *(const LAS u32x2*)(Yt + r32 * S3W_PITCH + cl * 2), zz = *(const LAS u32x2*)(Zt + r32 * S3W_PITCH + cl * 2);
                const float v0 = (bf_lo(yp.x) + ea * accs[pb][4 * rg]) * silu_f(bf_lo(zz.x)), v1 = (bf_hi(yp.x) + ea * accs[pb][4 * rg + 1]) * silu_f(bf_hi(zz.x));
                const float v2 = (bf_lo(yp.y) + ea * accs[pb][4 * rg + 2]) * silu_f(bf_lo(zz.y)), v3 = (bf_hi(yp.y) + ea * accs[pb][4 * rg + 3]) * silu_f(bf_hi(zz.y));
                yk[r][pb][2 * rg] = cvt_pk(v0, v1); yk[r][pb][2 * rg + 1] = cvt_pk(v2, v3);
                ss += (v0 * v0 + v1 * v1) + (v2 * v2 + v3 * v3);
            }
        asm volatile("" ::: "memory");
    }
    ss += __shfl_xor(ss, 32);
    const float rs = rsqrtf(ss * (1.0f / 256.0f) + RMS_EPS);
#pragma unroll
    for (int r = 0; r < 4; ++r) {
        asm volatile("" ::: "memory");
#pragma unroll
        for (int pb = 0; pb < 2; ++pb)
#pragma unroll
            for (int rg = 0; rg < 4; ++rg) {
                const int cl = 32 * pb + 8 * rg + 4 * hi;
                const f32x4 gg = *(const f32x4*)(B.ng + 256 * g + 64 * r + cl);
                const unsigned p0 = yk[r][pb][2 * rg], p1 = yk[r][pb][2 * rg + 1];
                u32x2 w; w.x = cvt_pk(bf_lo(p0) * rs * gg[0], bf_hi(p0) * rs * gg[1]); w.y = cvt_pk(bf_lo(p1) * rs * gg[2], bf_hi(p1) * rs * gg[3]);
                *(LAS u32x2*)(Yt + r32 * S3W_PITCH + cl * 2) = w;
            }
        asm volatile("" ::: "memory");
#pragma unroll
        for (int i = 0; i < 4; ++i) *(u32x4*)(B.yn + (row0 + srow + 8 * i) * 2048 + 256 * g + 64 * r + 8 * sch) = *(const LAS u32x4*)(Yt + (srow + 8 * i) * S3W_PITCH + sch * 16);
    }
}
__device__ __forceinline__ void s3_phase(LAS unsigned char* lds, const Bufs& B) {
    const int tid = tid_l(), lane = tid & 63; const int wid = __builtin_amdgcn_readfirstlane(tid >> 6);
    LAS unsigned char* wl = lds + wid * S3W_BYTES;
    for (int wit = blockIdx.x * 8 + wid; wit < NB * NCHUNK * 8 * 4; wit += gridDim.x * 8) s3_wave_item(wl, B, wit, lane);
}
}
#define XB_TMO      128
#define XB_XCNT(j)  (256  + 64 * (j))
#define XB_XSUB(j)  (1280 + 64 * (j))
#define XB_XGEN(j)  (2304 + 64 * (j))
#define XB_TOP      3328
#define XB_TOPGEN   3392
#define XCD_BAR_WORDS 3456
#define XB_SPIN_CAP (1u << 18)

__device__ __forceinline__ unsigned xb_ld(unsigned* p)              { return __hip_atomic_load(p, __ATOMIC_RELAXED, __HIP_MEMORY_SCOPE_AGENT); }
__device__ __forceinline__ unsigned xb_add(unsigned* p, unsigned v) { return __hip_atomic_fetch_add(p, v, __ATOMIC_RELAXED, __HIP_MEMORY_SCOPE_AGENT); }
__device__ __forceinline__ unsigned xb_xcc_id() { return (unsigned)__builtin_amdgcn_s_getreg((3 << 11) | 20) & 0xFu; }
#define XB_SPIN(cond, bar) do { unsigned _sp = 0; while (cond) { __builtin_amdgcn_s_sleep(1); \
    if ((++_sp & 255u) == 0u) { if (xb_ld(&(bar)[XB_TMO])) break; if (_sp > XB_SPIN_CAP) { atomicAdd(&(bar)[XB_TMO], 1u); break; } } } } while (0)

struct XcdBarrier {
    unsigned* bar; unsigned x;
    volatile LAS unsigned* st;
};

__device__ __forceinline__ XcdBarrier xcd_barrier_post(unsigned* bar, volatile LAS unsigned* st) {
    XcdBarrier b; b.bar = bar; b.x = xb_xcc_id(); b.st = st;
    if (threadIdx.x == 0) (void)xb_add(&bar[XB_XCNT(b.x)], 1u);
    return b;
}
__device__ __forceinline__ void xcd_barrier_complete(unsigned* bar, unsigned x, unsigned& nloc, unsigned& nx) {
    const unsigned G = gridDim.x * gridDim.y * gridDim.z;
    unsigned sum, cnt, mine, sp = 0u;
    for (;;) {
        sum = 0u; cnt = 0u; mine = 0u;
#pragma unroll
        for (unsigned j = 0; j < 16; ++j) { const unsigned c = xb_ld(&bar[XB_XCNT(j)]); sum += c; cnt += (c > 0u) ? 1u : 0u; mine = (j == x) ? c : mine; }
        if (sum == G) break;
        __builtin_amdgcn_s_sleep(1);
        if ((++sp & 255u) == 0u) { if (xb_ld(&bar[XB_TMO])) break; if (sp > XB_SPIN_CAP) { atomicAdd(&bar[XB_TMO], 1u); break; } }
    }
    nloc = mine > 0u ? mine : 1u; nx = cnt > 0u ? cnt : 1u;
}

__device__ __forceinline__ void xcd_barrier(const XcdBarrier& b) {
    asm volatile("s_waitcnt vmcnt(0)" ::: "memory");
    __syncthreads();
    if (threadIdx.x == 0) {
        unsigned* bar = b.bar;
        __builtin_amdgcn_s_waitcnt(0);
        unsigned nloc = b.st[0], nx = b.st[1];
        if (nloc == 0u) { xcd_barrier_complete(bar, b.x, nloc, nx); b.st[0] = nloc; b.st[1] = nx; }
        const unsigned old = xb_add(&bar[XB_XSUB(b.x)], 1u);
        const unsigned gen = old / nloc;
        if (old + 1u == (gen + 1u) * nloc) {
            __builtin_amdgcn_fence(__ATOMIC_RELEASE, "agent");
            asm volatile("s_waitcnt vmcnt(0)" ::: "memory");
            const unsigned og = xb_add(&bar[XB_TOP], 1u);
            const unsigned tg = og / nx;
            if (og + 1u == (tg + 1u) * nx) xb_add(&bar[XB_TOPGEN], 1u);
            else XB_SPIN(xb_ld(&bar[XB_TOPGEN]) == tg, bar);
            __builtin_amdgcn_fence(__ATOMIC_ACQUIRE, "agent");
            xb_add(&bar[XB_XGEN(b.x)], 1u);
            asm volatile("s_waitcnt vmcnt(0)" ::: "memory");
        } else {
            XB_SPIN(xb_ld(&bar[XB_XGEN(b.x)]) == gen, bar);
            __builtin_amdgcn_fence(__ATOMIC_ACQUIRE, "agent");
            asm volatile("s_waitcnt vmcnt(0)" ::: "memory");
        }
    }
    __syncthreads();
}


__global__ void __launch_bounds__(512, 2) hybrid_fwd(Args a) {
    extern __shared__ __attribute__((aligned(16))) unsigned char lds_raw[];
    LAS unsigned char* lds = (LAS unsigned char*)lds_raw;
    cg::grid_group grid = cg::this_grid();
    volatile LAS unsigned* bst = (volatile LAS unsigned*)(lds + LDS_BYTES - 16);
    { const ArgsP a0 = get_args(); unsigned* bw = (unsigned*)(a0->ws + WS_BAR);
      if (tid_l() < 2) bst[tid_l()] = 0u;
      if (tid_l() == 0) (void)xb_add(bw + XB_XCNT(xb_xcc_id()), 1u);
      if (a0->ws == nullptr) grid.sync(); }
#define XSYNC() do { XcdBarrier xbar_; xbar_.bar = (unsigned*)(get_args()->ws + WS_BAR); xbar_.x = xb_xcc_id(); xbar_.st = bst; xcd_barrier(xbar_); } while (0)
#define GRID_SYNC() do { asm volatile("s_waitcnt vmcnt(0) lgkmcnt(0)" ::: "memory"); grid.sync(); __builtin_amdgcn_fence(__ATOMIC_ACQUIRE, "agent"); asm volatile("s_waitcnt vmcnt(0)" ::: "memory"); } while (0)
#define TAIL_CONVERT(NWG, LYR, MASK) do { const int rem_ = (NWG) % G; if (rem_ == 0) convert_layer(get_args(), (LYR), lds, (MASK), bx, G); else if (bx >= rem_) convert_layer(get_args(), (LYR), lds, (MASK), bx - rem_, G - rem_); } while (0)
#pragma unroll 1
    for (int step = 0; step < MAXSTEP; ++step) {
        const int layer = step >> 3, k = step & 7, kind = layer % 3;
        if (k == 0 && layer > 0) continue;
        const ArgsP a = get_args();
        unsigned char* ws = a->ws; float* rsp = (float*)(ws + WS_RSP); bf16* xb = (bf16*)(ws + WS_XB); bf16* ar = (bf16*)(ws + WS_AR);
        const int G = gridDim.x, bx = blockIdx.x;
#ifdef REPEAT_MASK
        const int nrep = (((REPEAT_MASK >> k) & 1) && !(k == 4 && kind == 1)) ? 2 : 1;
#else
        const int nrep = 1;
#endif
#pragma unroll 1
        for (int rep = 0; rep < nrep; ++rep) {
        const float alpha_mul = (rep + 1 == nrep) ? 1.0f : 0.0f;
        if (k == 0) {
#if !defined(NO_P0)
            if (layer == 0) init_rows(a);
            convert_layer(a, layer, lds, 63, bx, G);
#endif
        } else if (k == 1 || k == 6) {
            pg8::Gemm g{xb, (const bf16*)(ws + (k == 1 ? W_GU1 : W_GU2)), T, 2 * FF, DM}; pg8::StaticOrder S; S.init(T, 2 * FF, G, bx);
            pg8::EpiSwiGLU E{ar, rsp, FF};
#if !defined(NO_G1)
            pg8::gemm_phase<pg8::EpiSwiGLU, pg8::StaticOrder, true, true>(lds, g, S, E);
#endif
            if (k == 1 && layer > 0) TAIL_CONVERT((T / 256) * (2 * FF / 256), layer, 2 | 8);
            if (k == 6 && layer + 1 < DEPTH) TAIL_CONVERT((T / 256) * (2 * FF / 256), layer + 1, (kind == 1) ? (16 | 32) : (1 | 4 | 16 | 32));
        } else if (k == 2 || k == 7) {
            pg8::Gemm g{ar, (const bf16*)(ws + (k == 2 ? W_D1 : W_D2)), T, DM, FF}; pg8::StaticOrder S; S.init(T, DM, G, bx);
            pg8::EpiResid E{xb, rsp, 0.5f * alpha_mul};
#if !defined(NO_G2)
            pg8::gemm_phase<pg8::EpiResid, pg8::StaticOrder, true, true>(lds, g, S, E);
#endif
        } else if (k == 3) {
            const int n = (kind == 1) ? SSD_IN_PAD : 3 * DM;
            pg8::Gemm g{xb, (const bf16*)(ws + W_IN), T, n, DM}; pg8::StaticOrder S; S.init(T, n, G, bx);
            pg8::EpiSplit E;
            if (kind == 1) E = pg8::EpiSplit{ar, 2048, 8, (size_t)T * 2048, rsp, 1.0f, (float*)(ws + WS_DT), 24};
            else E = pg8::EpiSplit{ar, 1024, 4, (size_t)T * 1024, rsp, (kind == 0) ? SB_C2 : 1.0f, nullptr, -1};
#if !defined(NO_G3)
            pg8::gemm_phase<pg8::EpiSplit, pg8::StaticOrder, true, true>(lds, g, S, E);
#endif
            if (kind == 1 && layer + 1 < DEPTH) TAIL_CONVERT((T / 256) * (SSD_IN_PAD / 256), layer + 1, 1 | 4);
        } else if (k == 4) {
            if (kind == 0) {
#if !defined(NO_SBA)
                sba::phase(lds, ar, ar + (size_t)T * 1024, ar + (size_t)2 * T * 1024, ar + (size_t)3 * T * 1024);
#endif
            } else if (kind == 1) {
                ssd::Bufs B;
                B.z = ar; B.xs_raw = ar + (size_t)T * 2048; B.bc_raw = ar + (size_t)2 * T * 2048; B.ypart = ar + (size_t)3 * T * 2048; B.states = ar + (size_t)4 * T * 2048;
                B.hprev = ar + (size_t)T * 2048; B.yn = ar + (size_t)4 * T * 2048; B.cc = (bf16*)a->out;
                B.dt_raw = (const float*)(ws + WS_DT); B.acum = (float*)(ws + WS_ACUM); B.alast = (float*)(ws + WS_ALAST);
                B.conv_w = a->in[11]; B.conv_b = a->in[12]; B.dt_bias = a->in[13]; B.a_log = a->in[14]; B.dsk = a->in[15]; B.ng = a->in[16];
#if !defined(NO_S1)
                for (int it = bx; it < NB * NCHUNK * 8; it += G) ssd::s1_item(lds, B, it);
#endif
                XSYNC();
#if !defined(NO_S2)
                ssd::s2_phase(B);
#endif
                XSYNC();
#if !defined(NO_S3)
                ssd::s3_phase(lds, B);
#endif
            } else {
#if !defined(NO_SC)
                shortconv_phase(ar, ar + (size_t)T * 1024, ar + (size_t)2 * T * 1024, a->in[19] + (size_t)(layer / 3) * 3 * DM, ar + (size_t)3 * T * 1024);
#endif
            }
        } else {
            const int kk = (kind == 1) ? 2 * DM : DM;
#ifdef DBG_AZ
            const bf16* A = (kind == 1) ? ar + (size_t)DBG_AZ * T * 2048 : ar + (size_t)3 * T * 1024;
#else
            const bf16* A = (kind == 1) ? ar + (size_t)4 * T * 2048 : ar + (size_t)3 * T * 1024;
#endif
            pg8::Gemm g{A, (const bf16*)(ws + W_OUT), T, DM, kk}; pg8::StaticOrder S; S.init(T, DM, G, bx);
            pg8::EpiResid E{xb, rsp, alpha_mul};
#if !defined(NO_G4)
            pg8::gemm_phase<pg8::EpiResid, pg8::StaticOrder, true, true>(lds, g, S, E);
#endif
        }
        XSYNC();
#ifdef REPEAT_SYNC
        XSYNC();
#endif
        }
    }
    final_norm(get_args());
}

extern "C" void kernel_launch(void* const* d_in, const int* in_sizes, int n_in, void* d_out, int out_size, void* d_ws, size_t ws_size, hipStream_t stream) {
    static int grid = 0;
    if (grid == 0) {
        if (n_in != 22 || out_size != T * DM || ws_size < WS_END) { fprintf(stderr, "kernel_launch: unexpected shapes: n_in %d out %d ws %zu (need %zu)\n", n_in, out_size, ws_size, (size_t)WS_END); grid = -1; return; }
        int dev = 0, cus = 0, per_cu = 0;
        hipGetDevice(&dev); hipDeviceGetAttribute(&cus, hipDeviceAttributeMultiprocessorCount, dev);
        if (hipFuncSetAttribute((const void*)hybrid_fwd, hipFuncAttributeMaxDynamicSharedMemorySize, LDS_BYTES) != hipSuccess) { fprintf(stderr, "kernel_launch: hipFuncSetAttribute failed\n"); grid = -1; return; }
        if (hipOccupancyMaxActiveBlocksPerMultiprocessor(&per_cu, (const void*)hybrid_fwd, 512, LDS_BYTES) != hipSuccess || per_cu < 1) { fprintf(stderr, "kernel_launch: occupancy query gave %d\n", per_cu); per_cu = 1; }
        (void)hipGetLastError();
        grid = cus * per_cu;
        fprintf(stderr, "kernel_launch: grid %d (%d CUs x %d)\n", grid, cus, per_cu);
    }
    if (grid < 0) return;
    Args a{};
    for (int i = 0; i < 22; ++i) a.in[i] = (const float*)d_in[i];
    a.out = (float*)d_out; a.ws = (unsigned char*)d_ws;
    if (hipMemsetAsync((char*)d_ws + WS_BAR, 0, XCD_BAR_WORDS * 4, stream) != hipSuccess) { fprintf(stderr, "kernel_launch: hipMemsetAsync failed\n"); return; }
    void* args[] = {&a};
    hipError_t e = hipLaunchCooperativeKernel((const void*)hybrid_fwd, dim3(grid), dim3(512), args, LDS_BYTES, stream);
    if (e != hipSuccess) fprintf(stderr, "kernel_launch: cooperative launch failed: %s (grid %d)\n", hipGetErrorString(e), grid);
}
```
